# Optimizing an MI355X kernel written in HIP

```python
import jax, jax.numpy as jnp
from jax import lax
import numpy as np

D_MODEL = 1024
BATCH = 8
SEQ = 2048
DEPTH = 2

HEAD_DIM = 64
ROT_DIM = HEAD_DIM // 4
ROPE_THETA = 500000.0
DIL_GROUPS = ((128, 1), (512, 4), (2048, 16))
N_GROUPS = len(DIL_GROUPS)
HEADS_PER_GROUP = 8
GROUP_WIDTH = HEADS_PER_GROUP * HEAD_DIM
BLOCK = 128
N_MEM = 256
MEM_HEADS = 4
MEM_WIDTH = MEM_HEADS * HEAD_DIM
CONV_WIDTH = D_MODEL
CONV_K = 3
N_MIXERS = 2
N_ATTN_LAYERS = (DEPTH + 1) // 2
N_CONV_LAYERS = DEPTH // 2
BRANCH_A = GROUP_WIDTH + MEM_WIDTH
BRANCH_B = CONV_WIDTH + MEM_WIDTH
IN_A = 3 * N_GROUPS * GROUP_WIDTH + MEM_WIDTH + BRANCH_A
IN_B = 3 * CONV_WIDTH + MEM_WIDTH + BRANCH_B
EPS = 1e-6

kernel_name = "hybrid_dilated_attn_shortconv_memory"


def rms_norm(x, g):
    xf = x.astype(jnp.float32)
    y = xf * lax.rsqrt(jnp.mean(xf * xf, axis=-1, keepdims=True) + EPS)
    return (y * g.astype(jnp.float32)).astype(x.dtype)


def partial_rope(t, positions):
    half = ROT_DIM // 2
    inv_freq = ROPE_THETA ** (-jnp.arange(half, dtype=jnp.float32) * (2.0 / ROT_DIM))
    ang = positions.astype(jnp.float32)[:, :, None] * inv_freq
    cos = jnp.cos(ang)[:, :, None, :]
    sin = jnp.sin(ang)[:, :, None, :]
    tr = t[..., :ROT_DIM].astype(jnp.float32)
    t1, t2 = tr[..., :half], tr[..., half:]
    rot = jnp.concatenate([t1 * cos - t2 * sin, t2 * cos + t1 * sin], axis=-1)
    return jnp.concatenate([rot.astype(t.dtype), t[..., ROT_DIM:]], axis=-1)


def dilated_window_attention(q, k, v, window, dilation):
    b, s, h, dh = q.shape
    n_stream = s // dilation
    span = window // dilation
    nb = -(-n_stream // BLOCK)
    lp = nb * BLOCK

    def to_streams(t):
        t = t.reshape(b, n_stream, dilation, h, dh).transpose(0, 2, 1, 3, 4)
        return jnp.pad(t, ((0, 0), (0, 0), (0, lp - n_stream), (0, 0), (0, 0)))

    def banded(t):
        t = jnp.pad(t, ((0, 0), (0, 0), (BLOCK, 0), (0, 0), (0, 0)))
        t = t.reshape(b, dilation, nb + 1, BLOCK, h, dh)
        return jnp.concatenate([t[:, :, :-1], t[:, :, 1:]], axis=3)

    qb = to_streams(q).reshape(b, dilation, nb, BLOCK, h, dh)
    kb = banded(to_streams(k))
    vb = banded(to_streams(v))

    scores = jnp.einsum('brnqhd,brnkhd->brnhqk', qb, kb).astype(jnp.float32) * (dh ** -0.5)
    qi = jnp.arange(BLOCK)[:, None]
    kj = jnp.arange(2 * BLOCK)[None, :]
    blk = jnp.arange(nb)[:, None, None]
    dist = qi + BLOCK - kj
    kpos = blk * BLOCK + kj - BLOCK
    valid = (dist >= 0) & (dist <= span) & (kpos >= 0)
    scores = jnp.where(valid[None, None, :, None], scores, -jnp.inf)
    lse = jax.nn.logsumexp(scores, axis=-1)
    p = jnp.exp(scores - lse[..., None])
    out = jnp.einsum('brnhqk,brnkhd->brnqhd', p.astype(vb.dtype), vb).astype(jnp.float32)

    out = out.reshape(b, dilation, lp, h, dh)[:, :, :n_stream]
    out = out.transpose(0, 2, 1, 3, 4).reshape(b, s, h, dh)
    lse = lse.transpose(0, 1, 2, 4, 3).reshape(b, dilation, lp, h)[:, :, :n_stream]
    lse = lse.transpose(0, 2, 1, 3).reshape(b, s, h)
    return out, lse


def memory_cross_attention(qm, mem_n, w_mem_kv):
    b, s, _ = qm.shape
    kv = mem_n @ w_mem_kv
    km, vm = jnp.split(kv, 2, axis=-1)
    km = km.reshape(b, N_MEM, MEM_HEADS, HEAD_DIM)
    vm = vm.reshape(b, N_MEM, MEM_HEADS, HEAD_DIM)
    qh = qm.reshape(b, s, MEM_HEADS, HEAD_DIM)
    scores = jnp.einsum('bshd,bmhd->bhsm', qh, km).astype(jnp.float32) * (HEAD_DIM ** -0.5)
    p = jax.nn.softmax(scores, axis=-1)
    out = jnp.einsum('bhsm,bmhd->bshd', p.astype(vm.dtype), vm)
    return out.reshape(b, s, MEM_WIDTH)


def dilated_attention_layer(hn, positions, mem_n, w_in, w_mem_kv, w_out):
    b, s, _ = hn.shape
    gw = N_GROUPS * GROUP_WIDTH
    proj = hn @ w_in
    q, k, v, qm, z = jnp.split(proj, [gw, 2 * gw, 3 * gw, 3 * gw + MEM_WIDTH], axis=-1)
    n_heads = N_GROUPS * HEADS_PER_GROUP
    q = partial_rope(q.reshape(b, s, n_heads, HEAD_DIM), positions)
    k = partial_rope(k.reshape(b, s, n_heads, HEAD_DIM), positions)
    v = v.reshape(b, s, n_heads, HEAD_DIM)
    outs, lses = [], []
    for g, (window, dilation) in enumerate(DIL_GROUPS):
        sl = slice(g * HEADS_PER_GROUP, (g + 1) * HEADS_PER_GROUP)
        o, l = dilated_window_attention(q[:, :, sl], k[:, :, sl], v[:, :, sl], window, dilation)
        outs.append(o)
        lses.append(l)
    wts = jax.nn.softmax(jnp.stack(lses, axis=0), axis=0)
    mix = jnp.sum(wts[..., None] * jnp.stack(outs, axis=0), axis=0)
    mix = mix.reshape(b, s, GROUP_WIDTH).astype(hn.dtype)
    mem_out = memory_cross_attention(qm, mem_n, w_mem_kv)
    y = jnp.concatenate([mix, mem_out], axis=-1) * jax.nn.silu(z)
    return y @ w_out


def short_conv_layer(hn, mem_n, w_in, conv_w, w_mem_kv, w_out):
    c = CONV_WIDTH
    proj = hn @ w_in
    bg, cg, u, qm, z = jnp.split(proj, [c, 2 * c, 3 * c, 3 * c + MEM_WIDTH], axis=-1)
    conv = lax.conv_general_dilated(
        cg * u, conv_w[:, None, :].astype(u.dtype),
        window_strides=(1,), padding=((CONV_K - 1, 0),),
        dimension_numbers=('NWC', 'WIO', 'NWC'), feature_group_count=c)
    mix = bg * conv
    mem_out = memory_cross_attention(qm, mem_n, w_mem_kv)
    y = jnp.concatenate([mix, mem_out], axis=-1) * jax.nn.silu(z)
    return y @ w_out


def setup_inputs(seed: int = 0) -> dict:
    key = jax.random.key(seed)
    ks = jax.random.split(key, 14)
    f32 = jnp.float32

    def nrm(k, shape, fan_in):
        return jax.random.normal(k, shape, f32) * (fan_in ** -0.5)

    x = jax.random.normal(ks[0], (BATCH, SEQ, D_MODEL), f32)
    mem = jax.random.normal(ks[1], (BATCH, N_MEM, D_MODEL), f32)
    offset = jax.random.randint(ks[2], (BATCH, 1), 0, 1024, dtype=jnp.int32)
    positions = offset + jnp.arange(SEQ, dtype=jnp.int32)[None, :]
    norm_g = 1.0 + 0.05 * jax.random.normal(ks[3], (DEPTH, D_MODEL), f32)
    mem_norm_g = 1.0 + 0.05 * jax.random.normal(ks[4], (DEPTH, D_MODEL), f32)
    w_mem_kv = nrm(ks[5], (DEPTH, D_MODEL, 2 * MEM_WIDTH), D_MODEL)
    attn_w_in = nrm(ks[6], (N_ATTN_LAYERS, D_MODEL, IN_A), D_MODEL)
    attn_w_out = nrm(ks[7], (N_ATTN_LAYERS, BRANCH_A, D_MODEL), BRANCH_A)
    conv_w_in = nrm(ks[8], (N_CONV_LAYERS, D_MODEL, IN_B), D_MODEL)
    conv_w = nrm(ks[9], (N_CONV_LAYERS, CONV_K, CONV_WIDTH), CONV_K)
    conv_w_out = nrm(ks[10], (N_CONV_LAYERS, BRANCH_B, D_MODEL), BRANCH_B)
    final_g = 1.0 + 0.05 * jax.random.normal(ks[11], (D_MODEL,), f32)
    return {"x": x, "mem": mem, "positions": positions, "norm_g": norm_g,
            "mem_norm_g": mem_norm_g, "w_mem_kv": w_mem_kv,
            "attn_w_in": attn_w_in, "attn_w_out": attn_w_out,
            "conv_w_in": conv_w_in, "conv_w": conv_w, "conv_w_out": conv_w_out,
            "final_g": final_g}


def reference(x, mem, positions, norm_g, mem_norm_g, w_mem_kv, attn_w_in, attn_w_out,
              conv_w_in, conv_w, conv_w_out, final_g):
    h = x
    for i in range(DEPTH):
        j = i // N_MIXERS
        hn = rms_norm(h, norm_g[i])
        mem_n = rms_norm(mem, mem_norm_g[i])
        if i % N_MIXERS == 0:
            delta = dilated_attention_layer(hn, positions, mem_n, attn_w_in[j],
                                            w_mem_kv[i], attn_w_out[j])
        else:
            delta = short_conv_layer(hn, mem_n, conv_w_in[j], conv_w[j],
                                     w_mem_kv[i], conv_w_out[j])
        h = h + delta
    return rms_norm(h, final_g)
```

```cpp
#include <hip/hip_runtime.h>
#include <hip/hip_cooperative_groups.h>
#include <cstdio>
#include <cstdint>
namespace cg = cooperative_groups;
#ifndef MK_PER_PHASE
#define MK_PER_PHASE 0
#endif
namespace pg8 {
#define PG8_LAS __attribute__((address_space(3)))
typedef unsigned short bf16_t;
typedef short bf16x8 __attribute__((ext_vector_type(8)));
typedef float f32x4 __attribute__((ext_vector_type(4)));
typedef unsigned u32x4 __attribute__((ext_vector_type(4)));
constexpr int BM = 256, BK = 64, HALF = 128, HTB = HALF * BK * 2  , STAGE_BYTES = 8 * HTB, NXCD = 8, WGM = 8;

__host__ __device__ __forceinline__ int lds_byte(int r, int c) { const int st = (r >> 4) * 2 + (c >> 5), rr = r & 15, cc = c & 31, ob = rr * 64 + cc * 2; return st * 1024 + (ob ^ (((ob >> 9) & 1) << 5)); }
__host__ __device__ __forceinline__ void stage_rc(int b, int& R, int& C) { const int st = b / 1024, sb = b % 1024, swz = sb ^ (((sb >> 9) & 1) << 5); R = (st >> 1) * 16 + swz / 64; C = (st & 1) * 32 + (swz % 64) / 2; }
__host__ __device__ __forceinline__ int perm32(int rho) { const int n = rho >> 4, i = rho & 15; return 8 * (i >> 2) + 4 * n + (i & 3); }

struct Unit { int pm, pn; };
struct Gemm { const bf16_t* A; const bf16_t* Bt; int M, N, K; };

struct StaticOrder {
    int nM, nN, nwg, G, c;
    __host__ __device__ void init(int M, int N, int G_, int c_) { nM = M / BM; nN = N / BM; nwg = nM * nN; G = G_; c = c_; }
    __host__ __device__ bool next(int i, Unit& u) const {
        const long L = (long)i * G + c; if (L >= nwg) return false;
        int wgid = (int)L; { const int q = nwg / NXCD, r = nwg % NXCD, xcd = wgid % NXCD, off = wgid / NXCD; wgid = (xcd < r ? xcd * (q + 1) : r * (q + 1) + (xcd - r) * q) + off; }
        const int nig = WGM * nN, gid = wgid / nig, fm = gid * WGM, gsz = (nM - fm) < WGM ? (nM - fm) : WGM;
        u.pm = fm + ((wgid % nig) % gsz); u.pn = (wgid % nig) / gsz; return true;
    }
    __device__ __forceinline__ void a_ready(const Unit&) const {}
    __device__ __forceinline__ void done(const Unit&) const {}
};
__device__ __forceinline__ unsigned cvt_pk_bf16(float lo, float hi) { unsigned r; asm volatile("v_cvt_pk_bf16_f32 %0, %1, %2" : "=v"(r) : "v"(lo), "v"(hi)); return r; }
typedef float f32x2 __attribute__((ext_vector_type(2)));
constexpr float QK_C2 = 0.125f * 1.4426950408889634f;
struct EpiPlain {
    static constexpr bool PERM = true, AFTER_DRAIN = false;
    bf16_t* O; int ldc;
    __device__ __forceinline__ void operator()(f32x4 (&acc)[2][2][4][2], const Unit& u, int wr, int wc, int fr, int fq) const {
        const int row0 = u.pm * BM + wr * 64 + fr, col0 = u.pn * BM + wc * 32 + 8 * fq;
#pragma unroll
        for (int ai = 0; ai < 2; ++ai)
#pragma unroll
            for (int m = 0; m < 4; ++m) { bf16_t* rowp = O + (size_t)(row0 + ai * HALF + m * 16) * ldc + col0;
#pragma unroll
                for (int bj = 0; bj < 2; ++bj) { const f32x4 v0 = acc[ai][bj][m][0], v1 = acc[ai][bj][m][1];
                    u32x4 w; w.x = cvt_pk_bf16(v0[0], v0[1]); w.y = cvt_pk_bf16(v0[2], v0[3]); w.z = cvt_pk_bf16(v1[0], v1[1]); w.w = cvt_pk_bf16(v1[2], v1[3]);
                    *(u32x4*)(rowp + bj * HALF) = w; } }
    }
};
struct EpiProj0 {
    static constexpr bool PERM = true, AFTER_DRAIN = false;
    bf16_t* O; int ldc; const float* rope;
    __device__ __forceinline__ void operator()(f32x4 (&acc)[2][2][4][2], const Unit& u, int wr, int wc, int fr, int fq) const {
        const int pn = u.pn, row0 = u.pm * BM + wr * 64 + fr, col0 = pn * BM + wc * 32 + 8 * fq;
        if (pn < 12 && (wc & 1) == 0) {
            const float sgn = fq == 0 ? -1.f : 1.f; const bool act = fq < 2;
#pragma unroll
            for (int ai = 0; ai < 2; ++ai)
#pragma unroll
                for (int m = 0; m < 4; ++m) { const f32x4* rp = (const f32x4*)(rope + (size_t)(row0 + ai * HALF + m * 16) * 16);
                    const f32x4 c0 = rp[0], c1 = rp[1], s0 = rp[2], s1 = rp[3];
#pragma unroll
                    for (int bj = 0; bj < 2; ++bj) { const f32x4 v0 = acc[ai][bj][m][0], v1 = acc[ai][bj][m][1]; f32x4 p0, p1;
#pragma unroll
                        for (int k = 0; k < 4; ++k) { p0[k] = __shfl_xor(v0[k], 16); p1[k] = __shfl_xor(v1[k], 16); }
                        if (act) { acc[ai][bj][m][0] = v0 * c0 + (p0 * s0) * sgn; acc[ai][bj][m][1] = v1 * c1 + (p1 * s1) * sgn; } } }
        }
        const float sc = (pn < 6 || pn == 18) ? QK_C2 : 1.f;
#pragma unroll
        for (int ai = 0; ai < 2; ++ai)
#pragma unroll
            for (int m = 0; m < 4; ++m) { bf16_t* rowp = O + (size_t)(row0 + ai * HALF + m * 16) * ldc + col0;
#pragma unroll
                for (int bj = 0; bj < 2; ++bj) { const f32x4 v0 = acc[ai][bj][m][0] * sc, v1 = acc[ai][bj][m][1] * sc;
                    u32x4 w; w.x = cvt_pk_bf16(v0[0], v0[1]); w.y = cvt_pk_bf16(v0[2], v0[3]); w.z = cvt_pk_bf16(v1[0], v1[1]); w.w = cvt_pk_bf16(v1[2], v1[3]);
                    *(u32x4*)(rowp + bj * HALF) = w; } }
    }
};
struct EpiH1 {
    static constexpr bool PERM = true, AFTER_DRAIN = false;
    const float* x; float* h1; bf16_t* h1b; float* ssq;
    __device__ __forceinline__ void operator()(f32x4 (&acc)[2][2][4][2], const Unit& u, int wr, int wc, int fr, int fq) const {
        const int row0 = u.pm * BM + wr * 64 + fr, col0 = u.pn * BM + wc * 32 + 8 * fq;
#pragma unroll
        for (int ai = 0; ai < 2; ++ai)
#pragma unroll
            for (int m = 0; m < 4; ++m) { const int row = row0 + ai * HALF + m * 16; const size_t off = (size_t)row * 1024 + col0; float ss = 0.f;
#pragma unroll
                for (int bj = 0; bj < 2; ++bj) { const f32x4 x0 = *(const f32x4*)(x + off + bj * HALF), x1 = *(const f32x4*)(x + off + bj * HALF + 4);
                    const f32x4 v0 = acc[ai][bj][m][0] + x0, v1 = acc[ai][bj][m][1] + x1;
                    *(f32x4*)(h1 + off + bj * HALF) = v0; *(f32x4*)(h1 + off + bj * HALF + 4) = v1;
                    u32x4 w; w.x = cvt_pk_bf16(v0[0], v0[1]); w.y = cvt_pk_bf16(v0[2], v0[3]); w.z = cvt_pk_bf16(v1[0], v1[1]); w.w = cvt_pk_bf16(v1[2], v1[3]);
                    *(u32x4*)(h1b + off + bj * HALF) = w;
                    ss += (v0[0] * v0[0] + v0[1] * v0[1]) + (v0[2] * v0[2] + v0[3] * v0[3]) + (v1[0] * v1[0] + v1[1] * v1[1]) + (v1[2] * v1[2] + v1[3] * v1[3]); }
                ss += __shfl_xor(ss, 16); ss += __shfl_xor(ss, 32);
                if (fq == 0) ssq[(size_t)row * 16 + u.pn * 4 + wc] = ss; }
    }
};
struct EpiProj1 {
    static constexpr bool PERM = true, AFTER_DRAIN = false;
    bf16_t* O; int ldc; const float* ssq;
    __device__ __forceinline__ void operator()(f32x4 (&acc)[2][2][4][2], const Unit& u, int wr, int wc, int fr, int fq) const {
        const int row0 = u.pm * BM + wr * 64 + fr, col0 = u.pn * BM + wc * 32 + 8 * fq; const float sc = (u.pn == 12) ? QK_C2 : 1.f;
#pragma unroll
        for (int ai = 0; ai < 2; ++ai)
#pragma unroll
            for (int m = 0; m < 4; ++m) { const int row = row0 + ai * HALF + m * 16; const f32x4* sp = (const f32x4*)(ssq + (size_t)row * 16);
                const f32x4 a = sp[0], b = sp[1], c = sp[2], d = sp[3];
                const float tot = ((a[0] + a[1]) + (a[2] + a[3])) + ((b[0] + b[1]) + (b[2] + b[3])) + ((c[0] + c[1]) + (c[2] + c[3])) + ((d[0] + d[1]) + (d[2] + d[3]));
                const float r = sc / sqrtf(tot * (1.0f / 1024.0f) + 1e-6f);
                bf16_t* rowp = O + (size_t)row * ldc + col0;
#pragma unroll
                for (int bj = 0; bj < 2; ++bj) { const f32x4 v0 = acc[ai][bj][m][0] * r, v1 = acc[ai][bj][m][1] * r;
                    u32x4 w; w.x = cvt_pk_bf16(v0[0], v0[1]); w.y = cvt_pk_bf16(v0[2], v0[3]); w.z = cvt_pk_bf16(v1[0], v1[1]); w.w = cvt_pk_bf16(v1[2], v1[3]);
                    *(u32x4*)(rowp + bj * HALF) = w; } }
    }
};
struct EpiH2 {
    static constexpr bool PERM = true, AFTER_DRAIN = false;
    float* h;
    __device__ __forceinline__ void operator()(f32x4 (&acc)[2][2][4][2], const Unit& u, int wr, int wc, int fr, int fq) const {
        const int row0 = u.pm * BM + wr * 64 + fr, col0 = u.pn * BM + wc * 32 + 8 * fq;
#pragma unroll
        for (int ai = 0; ai < 2; ++ai)
#pragma unroll
            for (int m = 0; m < 4; ++m) { const size_t off = (size_t)(row0 + ai * HALF + m * 16) * 1024 + col0;
#pragma unroll
                for (int bj = 0; bj < 2; ++bj) { const f32x4 x0 = *(const f32x4*)(h + off + bj * HALF), x1 = *(const f32x4*)(h + off + bj * HALF + 4);
                    *(f32x4*)(h + off + bj * HALF) = acc[ai][bj][m][0] + x0; *(f32x4*)(h + off + bj * HALF + 4) = acc[ai][bj][m][1] + x1; } }
    }
};

template <class Epi, class Sched, bool ALIGN_EPI = false, bool SP2 = false>
__device__ __forceinline__ void gemm_phase(PG8_LAS unsigned char* lds, const Gemm g, const Sched& S, const Epi& E) {
    const int tid = threadIdx.x, wid = __builtin_amdgcn_readfirstlane(tid >> 6), lane = tid & 63, wr = wid >> 2, wc = wid & 3, fr = lane & 15, fq = lane >> 4;
    const int K = g.K, nt = K / BK;
    unsigned voffA[2], voffB[2];
#pragma unroll
    for (int i = 0; i < 2; ++i) { int R, C; stage_rc(tid * 16 + i * 8192, R, C); const int Rb = Epi::PERM ? ((R & ~31) + perm32(R & 31)) : R;
        voffA[i] = (unsigned)(R * K + C) * 2u; voffB[i] = (unsigned)(Rb * K + C) * 2u; }
    const size_t kstep = (size_t)(BK * 2);
    const size_t hstep = (size_t)HALF * K * 2;
    const size_t tstep = 2 * hstep;
    const unsigned ldsw = (unsigned)wid * 1024u;
    const int aoff = lds_byte(wr * 64 + fr, fq * 8), boff = lds_byte(wc * 32 + fr, fq * 8);
#define PG8_SA(b, h) (((b) * 2 + (h)) * HTB)
#define PG8_SB(b, h) ((4 + (b) * 2 + (h)) * HTB)
#define PG8_STAGE(bufoff, gbase, voff) do { _Pragma("unroll") for (int _i = 0; _i < 2; ++_i) \
        __builtin_amdgcn_global_load_lds((const unsigned*)((const char*)(gbase) + (voff)[_i]), (PG8_LAS unsigned*)(lds + (bufoff) + ldsw + _i * 8192), 16, 0, 0); } while (0)
#define PG8_LDA(dst, b, h) do { _Pragma("unroll") for (int m = 0; m < 4; ++m) _Pragma("unroll") for (int k = 0; k < 2; ++k) dst[m][k] = *(const PG8_LAS bf16x8*)(lds + PG8_SA(b, h) + aoff + m * 2048 + k * 1024); } while (0)
#define PG8_LDB(dst, b, h) do { _Pragma("unroll") for (int n = 0; n < 2; ++n) _Pragma("unroll") for (int k = 0; k < 2; ++k) dst[n][k] = *(const PG8_LAS bf16x8*)(lds + PG8_SB(b, h) + boff + n * 2048 + k * 1024); } while (0)
#define PG8_MMA(ai, bj, At, Bt) do { __builtin_amdgcn_s_setprio(1); _Pragma("unroll") for (int m = 0; m < 4; ++m) _Pragma("unroll") for (int n = 0; n < 2; ++n) _Pragma("unroll") for (int k = 0; k < 2; ++k) \
        acc[ai][bj][m][n] = __builtin_amdgcn_mfma_f32_16x16x32_bf16(Bt[n][k], At[m][k], acc[ai][bj][m][n], 0, 0, 0); __builtin_amdgcn_s_setprio(0); } while (0)
#define PG8_WAIT_V(n) asm volatile("s_waitcnt vmcnt(" #n ")" ::: "memory")
#define PG8_WAIT_L(n) asm volatile("s_waitcnt lgkmcnt(" #n ")" ::: "memory")
#define PG8_BAR __builtin_amdgcn_s_barrier()
#define PG8_SCHED __builtin_amdgcn_sched_barrier(0)
    Unit cur, nxt; int ui = 0;
    if (!S.next(0, cur)) return;
    f32x4 acc[2][2][4][2];
#pragma unroll
    for (int a = 0; a < 2; ++a)
#pragma unroll
        for (int b = 0; b < 2; ++b)
#pragma unroll
            for (int m = 0; m < 4; ++m)
#pragma unroll
                for (int n = 0; n < 2; ++n) acc[a][b][m][n] = (f32x4){0.f, 0.f, 0.f, 0.f};
    bf16x8 At[4][2], B0[2][2], B1[2][2];
    const char* cA = (const char*)g.A + (size_t)cur.pm * tstep; const char* cB = (const char*)g.Bt + (size_t)cur.pn * tstep;
    S.a_ready(cur);
    if constexpr (SP2) {
        PG8_STAGE(PG8_SB(0, 0), cB, voffB); PG8_STAGE(PG8_SB(0, 1), cB + hstep, voffB); PG8_STAGE(PG8_SA(0, 0), cA, voffA); PG8_STAGE(PG8_SA(0, 1), cA + hstep, voffA);
        if (wr == 1) PG8_BAR;
        PG8_WAIT_V(2); PG8_BAR;
        PG8_STAGE(PG8_SB(1, 0), cB + kstep, voffB); PG8_STAGE(PG8_SA(1, 0), cA + kstep, voffA); PG8_STAGE(PG8_SB(1, 1), cB + hstep + kstep, voffB);
        PG8_WAIT_V(6); PG8_BAR;
    } else {
        PG8_STAGE(PG8_SB(0, 0), cB, voffB); PG8_STAGE(PG8_SA(0, 0), cA, voffA); PG8_STAGE(PG8_SB(0, 1), cB + hstep, voffB); PG8_STAGE(PG8_SA(0, 1), cA + hstep, voffA);
        if (wr == 1) PG8_BAR;
        PG8_WAIT_V(4); PG8_BAR;
        PG8_STAGE(PG8_SB(1, 0), cB + kstep, voffB); PG8_STAGE(PG8_SA(1, 0), cA + kstep, voffA); PG8_STAGE(PG8_SB(1, 1), cB + hstep + kstep, voffB);
        PG8_WAIT_V(6); PG8_BAR;
    }
    for (;;) {
        const bool has_next = S.next(ui + 1, nxt);
        const char* nA = has_next ? (const char*)g.A + (size_t)nxt.pm * tstep : cA; const char* nB = has_next ? (const char*)g.Bt + (size_t)nxt.pn * tstep : cB;
        for (int t = 0; t < nt; t += 2) {
            const bool last = (t == nt - 2);
            const char* a1 = cA + (size_t)(t + 1) * kstep;
            const char* a2 = last ? nA : cA + (size_t)(t + 2) * kstep; const char* b2 = last ? nB : cB + (size_t)(t + 2) * kstep;
            const char* a3 = a2 + kstep; const char* b3 = b2 + kstep;
            if (last && has_next) S.a_ready(nxt);
            if constexpr (SP2) {
            PG8_LDB(B0, 0, 0); PG8_LDB(B1, 0, 1); PG8_SCHED; PG8_LDA(At, 0, 0); PG8_STAGE(PG8_SA(1, 1), a1 + hstep, voffA);
            PG8_WAIT_V(8); PG8_WAIT_L(0); PG8_BAR; PG8_MMA(0, 0, At, B0); PG8_MMA(0, 1, At, B1); PG8_BAR; PG8_SCHED;
            PG8_LDA(At, 0, 1); PG8_STAGE(PG8_SB(0, 0), b2, voffB); PG8_STAGE(PG8_SB(0, 1), b2 + hstep, voffB); PG8_STAGE(PG8_SA(0, 0), a2, voffA);
            PG8_WAIT_V(8); PG8_WAIT_L(0); PG8_BAR; PG8_MMA(1, 0, At, B0); PG8_MMA(1, 1, At, B1); PG8_BAR; PG8_SCHED;
            PG8_LDB(B0, 1, 0); PG8_LDB(B1, 1, 1); PG8_SCHED; PG8_LDA(At, 1, 0); PG8_STAGE(PG8_SA(0, 1), a2 + hstep, voffA);
            PG8_WAIT_V(8); PG8_WAIT_L(0); PG8_BAR; PG8_MMA(0, 0, At, B0); PG8_MMA(0, 1, At, B1); PG8_BAR; PG8_SCHED;
            PG8_LDA(At, 1, 1); PG8_STAGE(PG8_SB(1, 0), b3, voffB); PG8_STAGE(PG8_SB(1, 1), b3 + hstep, voffB); PG8_STAGE(PG8_SA(1, 0), a3, voffA);
            PG8_WAIT_V(8); PG8_WAIT_L(0); PG8_BAR; PG8_MMA(1, 0, At, B0); PG8_MMA(1, 1, At, B1); PG8_BAR; PG8_SCHED;
            } else {
            PG8_LDB(B0, 0, 0); PG8_SCHED; PG8_LDA(At, 0, 0); PG8_STAGE(PG8_SA(1, 1), a1 + hstep, voffA);
            PG8_WAIT_L(8); PG8_BAR; PG8_WAIT_L(0); PG8_MMA(0, 0, At, B0); PG8_BAR; PG8_SCHED;
            PG8_LDB(B1, 0, 1); PG8_STAGE(PG8_SB(0, 0), b2, voffB);
            PG8_BAR; PG8_WAIT_L(0); PG8_MMA(0, 1, At, B1); PG8_BAR;
            PG8_LDA(At, 0, 1); PG8_STAGE(PG8_SA(0, 0), a2, voffA);
            PG8_BAR; PG8_WAIT_L(0); PG8_MMA(1, 0, At, B0); PG8_BAR; PG8_SCHED;
            PG8_STAGE(PG8_SB(0, 1), b2 + hstep, voffB);
            PG8_WAIT_V(6); PG8_BAR; PG8_MMA(1, 1, At, B1); PG8_BAR;
            PG8_LDB(B0, 1, 0); PG8_SCHED; PG8_LDA(At, 1, 0); PG8_STAGE(PG8_SA(0, 1), a2 + hstep, voffA);
            PG8_WAIT_L(8); PG8_BAR; PG8_WAIT_L(0); PG8_MMA(0, 0, At, B0); PG8_BAR; PG8_SCHED;
            PG8_LDB(B1, 1, 1); PG8_STAGE(PG8_SB(1, 0), b3, voffB);
            PG8_BAR; PG8_WAIT_L(0); PG8_MMA(0, 1, At, B1); PG8_BAR;
            PG8_LDA(At, 1, 1); PG8_STAGE(PG8_SA(1, 0), a3, voffA);
            PG8_BAR; PG8_WAIT_L(0); PG8_MMA(1, 0, At, B0); PG8_BAR; PG8_SCHED;
            PG8_STAGE(PG8_SB(1, 1), b3 + hstep, voffB);
            PG8_WAIT_V(6); PG8_BAR; PG8_MMA(1, 1, At, B1); PG8_BAR;
            }
        }
        if constexpr (ALIGN_EPI) { if (wr == 0) PG8_BAR; }
        if constexpr (!Epi::AFTER_DRAIN) { E(acc, cur, wr, wc, fr, fq); S.done(cur); }
        if (!has_next) break;
#pragma unroll
        for (int a = 0; a < 2; ++a)
#pragma unroll
            for (int b = 0; b < 2; ++b)
#pragma unroll
                for (int m = 0; m < 4; ++m)
#pragma unroll
                    for (int n = 0; n < 2; ++n) acc[a][b][m][n] = (f32x4){0.f, 0.f, 0.f, 0.f};
        cur = nxt; cA = nA; cB = nB; ++ui;
        if constexpr (ALIGN_EPI) { if (wr == 1) PG8_BAR; }
    }
    PG8_WAIT_V(0);
    if constexpr (!ALIGN_EPI) { if (wr == 0) PG8_BAR; }
    PG8_BAR;
    if constexpr (Epi::AFTER_DRAIN) { E.fused(acc, cur, wr, wc, fr, fq, lds, wid, lane); S.done(cur); }
#undef PG8_SA
#undef PG8_SB
#undef PG8_STAGE
#undef PG8_LDA
#undef PG8_LDB
#undef PG8_MMA
#undef PG8_WAIT_V
#undef PG8_WAIT_L
#undef PG8_BAR
#undef PG8_SCHED
}
}
constexpr int NB = 8, SEQ = 2048, DM = 1024, MT = NB * SEQ;
constexpr int INA = 5632, INB = 4608, BRA = 768, BRB = 1280, NMEM = 256, MEMROWS = NB * NMEM, KVW = 512;
constexpr float RMS_EPS = 1e-6f;
constexpr size_t MiB = 1u << 20;
constexpr size_t WS_WINA = 1 * MiB, WS_WINB = 12 * MiB, WS_WOA = 21 * MiB, WS_WOB = 23 * MiB, WS_WKV = 26 * MiB;
constexpr size_t WS_KV = 28 * MiB;
constexpr size_t WS_LSE = 32 * MiB;
constexpr size_t WS_ROPE = 34 * MiB;
constexpr size_t WS_SSQ = 35 * MiB;
constexpr size_t WS_HN = 36 * MiB;
constexpr size_t WS_MEMN = 68 * MiB;
constexpr size_t WS_PROJ = 76 * MiB;
constexpr size_t WS_H1B = 220 * MiB;
constexpr size_t WS_END = 252 * MiB;
static_assert(WS_PROJ + (size_t)MT * INA * 2 <= WS_END && WS_PROJ + (size_t)MT * INB * 2 <= WS_H1B && WS_HN + (size_t)MT * BRB * 2 <= WS_PROJ, "d_ws map");

#define LAS __attribute__((address_space(3)))
typedef unsigned short bf16;
typedef unsigned u32x4 __attribute__((ext_vector_type(4)));
typedef unsigned u32x2 __attribute__((ext_vector_type(2)));
typedef float f32x4 __attribute__((ext_vector_type(4)));
typedef short bf16x8 __attribute__((ext_vector_type(8)));
constexpr int NTHR = 512, NWAVES = 8;
constexpr int LDS_BYTES = 147456;

__device__ __forceinline__ unsigned f2bf(float f) { unsigned u = __builtin_bit_cast(unsigned, f); return (u + 0x7fffu + ((u >> 16) & 1u)) >> 16; }
__device__ __forceinline__ unsigned pk2(float lo, float hi) { return f2bf(lo) | (f2bf(hi) << 16); }
__device__ __forceinline__ float bflo(unsigned w) { return __builtin_bit_cast(float, w << 16); }
__device__ __forceinline__ float bfhi(unsigned w) { return __builtin_bit_cast(float, w & 0xffff0000u); }
__device__ __forceinline__ float wave_sum(float v) {
#pragma unroll
    for (int o = 1; o < 64; o <<= 1) v += __shfl_xor(v, o);
    return v;
}
__device__ __forceinline__ float silu(float z) { return z / (1.0f + __expf(-z)); }

__device__ __forceinline__ void p0_transpose_item(const float* W, int K, int N, bf16* WT, const float* g, LAS float* scr, int item, int lane) {
    const int nblk = N / 32, kb = item / nblk, nb = item % nblk, k0 = 64 * kb, n0 = 32 * nb;
#pragma unroll 8
    for (int i = 0; i < 32; ++i) { const int kk = 2 * i + (lane >> 5); float v = W[(size_t)(k0 + kk) * N + n0 + (lane & 31)]; if (g) v *= g[k0 + kk]; scr[kk * 33 + (lane & 31)] = v; }
    asm volatile("s_waitcnt lgkmcnt(0)" ::: "memory");
    const int c = lane & 7;
#pragma unroll
    for (int j = 0; j < 4; ++j) { const int n = (lane >> 3) + 8 * j; const LAS float* s = scr + (8 * c) * 33 + n;
        u32x4 o; o.x = pk2(s[0 * 33], s[1 * 33]); o.y = pk2(s[2 * 33], s[3 * 33]); o.z = pk2(s[4 * 33], s[5 * 33]); o.w = pk2(s[6 * 33], s[7 * 33]);
        *(u32x4*)(WT + (size_t)(n0 + n) * K + k0 + 8 * c) = o; }
    asm volatile("s_waitcnt lgkmcnt(0)" ::: "memory");
}
__device__ __forceinline__ void rms_row_to_bf16(const float* xrow, const float* g, bf16* orow, int lane) {
    const f32x4* xr = (const f32x4*)xrow + lane; const f32x4* gr = (const f32x4*)g + lane;
    f32x4 v[4]; float s = 0.f;
#pragma unroll
    for (int j = 0; j < 4; ++j) { v[j] = xr[64 * j]; s += (v[j].x * v[j].x + v[j].y * v[j].y) + (v[j].z * v[j].z + v[j].w * v[j].w); }
    const float r = 1.0f / sqrtf(wave_sum(s) * (1.f / DM) + RMS_EPS);
    unsigned long long* o8 = (unsigned long long*)orow + lane;
#pragma unroll
    for (int j = 0; j < 4; ++j) { const f32x4 gg = gr[64 * j]; o8[64 * j] = (unsigned long long)pk2(v[j].x * r * gg.x, v[j].y * r * gg.y) | ((unsigned long long)pk2(v[j].z * r * gg.z, v[j].w * r * gg.w) << 32); }
}

constexpr int KROWB = 144, VROWB = 544, LDS_KOFF = 0, LDS_VOFF = 256 * KROWB, ATT_LDS = LDS_VOFF + 64 * VROWB;
template <bool WIN>
__device__ __forceinline__ void attn_core(const LAS unsigned char* Kl, const LAS unsigned char* Vl, int q0, bf16x8 qf0, bf16x8 qf1, bool firstblk, int wave, int fr, int fq, f32x4 (&o)[4], float& lse2) {
    constexpr int NT = WIN ? 9 : 16, NK = WIN ? 5 : 8;
    const int kb0 = WIN ? q0 : 0;
    f32x4 s[NT];
#pragma unroll
    for (int t = 0; t < NT; ++t) {
        const LAS unsigned char* kp = Kl + (kb0 + 16 * t + fr) * KROWB + fq * 16;
        const bf16x8 a0 = *(const LAS bf16x8*)kp, a1 = *(const LAS bf16x8*)(kp + 64);
        f32x4 z = (f32x4){0.f, 0.f, 0.f, 0.f};
        z = __builtin_amdgcn_mfma_f32_16x16x32_bf16(a0, qf0, z, 0, 0, 0);
        s[t] = __builtin_amdgcn_mfma_f32_16x16x32_bf16(a1, qf1, z, 0, 0, 0);
    }
    if (WIN) {
        const int dd = fr - 4 * fq; const float NEG = -INFINITY;
#pragma unroll
        for (int i = 0; i < 4; ++i) { if (dd - i > 0) s[0][i] = NEG; if (dd - i < 0) s[NT - 1][i] = NEG; }
        if (firstblk) {
#pragma unroll
            for (int t = 0; t < NT - 1; ++t) if (wave + t < 8) s[t] = (f32x4){NEG, NEG, NEG, NEG};
        }
    }
    float m = s[0][0];
#pragma unroll
    for (int t = 0; t < NT; ++t) m = fmaxf(fmaxf(m, fmaxf(s[t][0], s[t][1])), fmaxf(s[t][2], s[t][3]));
    m = fmaxf(m, __shfl_xor(m, 16)); m = fmaxf(m, __shfl_xor(m, 32));
    float sum = 0.f;
#pragma unroll
    for (int t = 0; t < NT; ++t) {
#pragma unroll
        for (int i = 0; i < 4; ++i) { s[t][i] = __builtin_amdgcn_exp2f(s[t][i] - m); sum += s[t][i]; } }
    sum += __shfl_xor(sum, 16); sum += __shfl_xor(sum, 32);
    lse2 = m + __builtin_log2f(sum);
    bf16x8 pf[NK];
#pragma unroll
    for (int k = 0; k < NK; ++k) { u32x4 w; w.x = pg8::cvt_pk_bf16(s[2 * k][0], s[2 * k][1]); w.y = pg8::cvt_pk_bf16(s[2 * k][2], s[2 * k][3]);
        if (2 * k + 1 < NT) { w.z = pg8::cvt_pk_bf16(s[2 * k + 1][0], s[2 * k + 1][1]); w.w = pg8::cvt_pk_bf16(s[2 * k + 1][2], s[2 * k + 1][3]); } else { w.z = 0u; w.w = 0u; }
        pf[k] = __builtin_bit_cast(bf16x8, w); }
    const float inv = 1.0f / sum;
#pragma unroll
    for (int dt = 0; dt < 4; ++dt) {
        f32x4 acc = (f32x4){0.f, 0.f, 0.f, 0.f};
#pragma unroll
        for (int k = 0; k < NK; ++k) {
            const LAS unsigned char* vp = Vl + (16 * dt + fr) * VROWB + (kb0 + 32 * k + 4 * fq) * 2;
            const u32x2 lo = *(const LAS u32x2*)vp, hi = *(const LAS u32x2*)(vp + 32);
            const bf16x8 vf = __builtin_bit_cast(bf16x8, (u32x4){lo.x, lo.y, hi.x, hi.y});
            acc = __builtin_amdgcn_mfma_f32_16x16x32_bf16(vf, pf[k], acc, 0, 0, 0);
        }
        o[dt] = acc * inv;
    }
}
template <class RowOff>
__device__ __forceinline__ void attn_stage(LAS unsigned char* Kl, LAS unsigned char* Vl, const bf16* Kg, const bf16* Vg, const RowOff& rowoff, int tid) {
    u32x4 kv[4], vv[4];
#pragma unroll
    for (int i = 0; i < 4; ++i) { const int c = tid + NTHR * i, row = c >> 3, ch = c & 7; const size_t off = rowoff(row) + ch * 8;
        kv[i] = *(const u32x4*)(Kg + off); vv[i] = *(const u32x4*)(Vg + off); }
#pragma unroll
    for (int i = 0; i < 4; ++i) { const int c = tid + NTHR * i, row = c >> 3, ch = c & 7;
        *(LAS u32x4*)(Kl + row * KROWB + ch * 16) = kv[i];
#pragma unroll
        for (int j = 0; j < 8; ++j) { const unsigned w = vv[i][j >> 1]; *(LAS unsigned short*)(Vl + (ch * 8 + j) * VROWB + row * 2) = (unsigned short)((j & 1) ? (w >> 16) : (w & 0xffffu)); } }
}

struct Args { const float* x; const float* mem; const int* pos; const float* norm_g; const float* mem_norm_g; const float* w_mem_kv; const float* attn_w_in; const float* attn_w_out;
              const float* conv_w_in; const float* conv_w; const float* conv_w_out; const float* final_g; float* out; unsigned char* ws; int ph_lo, ph_hi; };

__device__ __forceinline__ void mem_attn_unit(int u, const bf16* proj, int ldp, int qcol, int zcol, const bf16* kvb, bf16* y, int ldy, int ycol, LAS unsigned char* lds, int tid, int wave, int fr, int fq) {
    const int b = u >> 6, h = (u >> 4) & 3, qb = u & 15;
    LAS unsigned char* Kl = lds + LDS_KOFF; LAS unsigned char* Vl = lds + LDS_VOFF;
    const bf16* Kg = kvb + (size_t)b * NMEM * KVW + h * 64;
    attn_stage(Kl, Vl, Kg, Kg + 256, [](int row) { return (size_t)row * KVW; }, tid);
    const size_t row = (size_t)b * SEQ + qb * 128 + wave * 16 + fr;
    const bf16* qp = proj + row * ldp + qcol + h * 64 + 8 * fq;
    const bf16x8 qf0 = *(const bf16x8*)qp, qf1 = *(const bf16x8*)(qp + 32);
    u32x2 zr[4];
#pragma unroll
    for (int dt = 0; dt < 4; ++dt) zr[dt] = *(const u32x2*)(proj + row * ldp + zcol + h * 64 + 16 * dt + 4 * fq);
    __syncthreads();
    f32x4 o[4]; float lse2;
    attn_core<false>(Kl, Vl, 0, qf0, qf1, false, wave, fr, fq, o, lse2);
#pragma unroll
    for (int dt = 0; dt < 4; ++dt) { u32x2 w; w.x = pk2(o[dt][0] * silu(bflo(zr[dt].x)), o[dt][1] * silu(bfhi(zr[dt].x))); w.y = pk2(o[dt][2] * silu(bflo(zr[dt].y)), o[dt][3] * silu(bfhi(zr[dt].y)));
        *(u32x2*)(y + row * ldy + ycol + h * 64 + 16 * dt + 4 * fq) = w; }
    __syncthreads();
}
__device__ __forceinline__ void dil_attn_unit(int u, bf16* proj, float* lse, LAS unsigned char* lds, int tid, int wave, int fr, int fq) {
    const int b = u / 384, rem = u % 384, hh = rem >> 4, idx = rem & 15, g = hh >> 3;
    const int dil = g == 0 ? 1 : (g == 1 ? 4 : 16), lgblk = g == 0 ? 4 : (g == 1 ? 2 : 0);
    const int r = idx >> lgblk, j = idx & ((1 << lgblk) - 1);
    LAS unsigned char* Kl = lds + LDS_KOFF; LAS unsigned char* Vl = lds + LDS_VOFF;
    const size_t base = (size_t)b * SEQ;
    attn_stage(Kl, Vl, proj + 1536 + hh * 64, proj + 3072 + hh * 64,
               [=](int row) { int p = 128 * (j - 1) + row; p = p < 0 ? 0 : p; return (base + (size_t)(p * dil + r)) * INA; }, tid);
    if (tid < 128) *(LAS u32x4*)(Vl + (tid >> 1) * VROWB + 512 + (tid & 1) * 16) = (u32x4){0u, 0u, 0u, 0u};
    const int q0 = wave * 16;
    const size_t row = base + (size_t)((128 * j + q0 + fr) * dil + r);
    bf16* qp = proj + row * INA + hh * 64;
    const bf16x8 qf0 = *(const bf16x8*)(qp + 8 * fq), qf1 = *(const bf16x8*)(qp + 32 + 8 * fq);
    __syncthreads();
    f32x4 o[4]; float lse2;
    attn_core<true>(Kl, Vl, q0, qf0, qf1, j == 0, wave, fr, fq, o, lse2);
#pragma unroll
    for (int dt = 0; dt < 4; ++dt) { u32x2 w; w.x = pk2(o[dt][0], o[dt][1]); w.y = pk2(o[dt][2], o[dt][3]); *(u32x2*)(qp + 16 * dt + 4 * fq) = w; }
    if (fq == 0) lse[((size_t)g * MT + row) * 8 + (hh & 7)] = lse2;
    __syncthreads();
}

__global__ void __launch_bounds__(NTHR, 2) fwd_megakernel(Args a) {
    extern __shared__ __attribute__((aligned(16))) unsigned char lds_raw[];
    LAS unsigned char* lds = (LAS unsigned char*)lds_raw;
    cg::grid_group grid = cg::this_grid();
    const int tid = threadIdx.x, lane = tid & 63, wave = __builtin_amdgcn_readfirstlane(tid >> 6), fr = lane & 15, fq = lane >> 4;
    const int G = gridDim.x, cb = blockIdx.x;
    const int gw = cb * NWAVES + wave, NGW = G * NWAVES;
    const size_t gt = (size_t)cb * NTHR + tid, NGT = (size_t)G * NTHR;
    unsigned char* ws = a.ws;
    bf16* WinA = (bf16*)(ws + WS_WINA); bf16* WinB = (bf16*)(ws + WS_WINB); bf16* WoA = (bf16*)(ws + WS_WOA); bf16* WoB = (bf16*)(ws + WS_WOB); bf16* Wkv = (bf16*)(ws + WS_WKV);
    bf16* KV = (bf16*)(ws + WS_KV); float* LSE = (float*)(ws + WS_LSE); float* ROPE = (float*)(ws + WS_ROPE); float* SSQ = (float*)(ws + WS_SSQ);
    bf16* HN = (bf16*)(ws + WS_HN); bf16* Y = HN; bf16* MEMN = (bf16*)(ws + WS_MEMN); bf16* PROJ = (bf16*)(ws + WS_PROJ); bf16* H1B = (bf16*)(ws + WS_H1B);
    const int lo = a.ph_lo, hi = a.ph_hi;
#define IN(k) (lo <= (k) && (k) < hi)
#define SEAM(k) do { if (IN(k) && IN((k) + 1)) grid.sync(); } while (0)

    if (IN(0)) {
        LAS float* scr = (LAS float*)(lds + wave * 16384);
        constexpr int I_A = 16 * (INA / 32), I_B = 16 * (INB / 32), I_OA = (BRA / 64) * 32, I_OB = (BRB / 64) * 32, I_KV = 16 * (KVW / 32);
        constexpr int NITEMS = I_A + I_B + I_OA + I_OB + 2 * I_KV;
        for (int it = gw; it < NITEMS; it += NGW) {
            int r = it;
            if (r < I_A) { p0_transpose_item(a.attn_w_in, DM, INA, WinA, nullptr, scr, r, lane); continue; } r -= I_A;
            if (r < I_B) { p0_transpose_item(a.conv_w_in, DM, INB, WinB, a.norm_g + DM, scr, r, lane); continue; } r -= I_B;
            if (r < I_OA) { p0_transpose_item(a.attn_w_out, BRA, DM, WoA, nullptr, scr, r, lane); continue; } r -= I_OA;
            if (r < I_OB) { p0_transpose_item(a.conv_w_out, BRB, DM, WoB, nullptr, scr, r, lane); continue; } r -= I_OB;
            if (r < I_KV) { p0_transpose_item(a.w_mem_kv, DM, KVW, Wkv, nullptr, scr, r, lane); continue; } r -= I_KV;
            p0_transpose_item(a.w_mem_kv + (size_t)DM * KVW, DM, KVW, Wkv + (size_t)KVW * DM, nullptr, scr, r, lane);
        }
        for (int m = gw; m < MT; m += NGW) rms_row_to_bf16(a.x + (size_t)m * DM, a.norm_g, HN + (size_t)m * DM, lane);
        for (int m = gw; m < 2 * MEMROWS; m += NGW) { const int L = m / MEMROWS, mr = m % MEMROWS; rms_row_to_bf16(a.mem + (size_t)mr * DM, a.mem_norm_g + L * DM, MEMN + (size_t)m * DM, lane); }
        for (size_t i = gt; i < (size_t)MT * 8; i += NGT) { const int row = (int)(i >> 3), j = (int)(i & 7);
            const float inv = (float)pow(500000.0, -(double)j * 0.125); const float ang = (float)a.pos[row] * inv;
            ROPE[(size_t)row * 16 + j] = (float)cos((double)ang); ROPE[(size_t)row * 16 + 8 + j] = (float)sin((double)ang); }
    }
    SEAM(0);
    if (IN(1)) {
        { pg8::Gemm g{HN, WinA, MT, INA, DM}; pg8::StaticOrder S; S.init(MT, INA, G, cb); pg8::EpiProj0 E{PROJ, INA, ROPE};
          pg8::gemm_phase<pg8::EpiProj0, pg8::StaticOrder, true, true>(lds, g, S, E); }
        const int c1 = cb - G / 2;
        if (c1 >= 0 && c1 < 16) { pg8::Gemm g{MEMN, Wkv, MEMROWS, KVW, DM}; pg8::StaticOrder S; S.init(MEMROWS, KVW, G, c1); pg8::EpiPlain E{KV, KVW};
          pg8::gemm_phase<pg8::EpiPlain, pg8::StaticOrder, true, true>(lds, g, S, E); }
        if (c1 >= 16 && c1 < 32) { pg8::Gemm g{MEMN + (size_t)MEMROWS * DM, Wkv + (size_t)KVW * DM, MEMROWS, KVW, DM}; pg8::StaticOrder S; S.init(MEMROWS, KVW, G, c1 - 16); pg8::EpiPlain E{KV + (size_t)MEMROWS * KVW, KVW};
          pg8::gemm_phase<pg8::EpiPlain, pg8::StaticOrder, true, true>(lds, g, S, E); }
    }
    SEAM(1);
    if (IN(2)) {
        for (int u = cb; u < 512; u += G) mem_attn_unit(u, PROJ, INA, 4608, 4864 + 512, KV, Y, BRA, 512, lds, tid, wave, fr, fq);
        for (int u = cb; u < 3072; u += G) dil_attn_unit(u, PROJ, LSE, lds, tid, wave, fr, fq);
    }
    SEAM(2);
    if (IN(3)) {
        for (size_t it = gt; it < (size_t)MT * 64; it += NGT) { const size_t row = it >> 6; const int c = (int)(it & 63), h = c >> 3;
            const float l0 = LSE[row * 8 + h], l1 = LSE[((size_t)MT + row) * 8 + h], l2 = LSE[((size_t)2 * MT + row) * 8 + h];
            const float mx = fmaxf(l0, fmaxf(l1, l2)); float w0 = __builtin_amdgcn_exp2f(l0 - mx), w1 = __builtin_amdgcn_exp2f(l1 - mx), w2 = __builtin_amdgcn_exp2f(l2 - mx);
            const float inv = 1.0f / (w0 + w1 + w2); w0 *= inv; w1 *= inv; w2 *= inv;
            const bf16* pr = PROJ + row * INA + c * 8;
            const u32x4 o0 = *(const u32x4*)pr, o1 = *(const u32x4*)(pr + 512), o2 = *(const u32x4*)(pr + 1024), z = *(const u32x4*)(pr + 4864);
            u32x4 y;
#pragma unroll
            for (int k = 0; k < 4; ++k) { const float mlo = w0 * bflo(o0[k]) + w1 * bflo(o1[k]) + w2 * bflo(o2[k]), mhi = w0 * bfhi(o0[k]) + w1 * bfhi(o1[k]) + w2 * bfhi(o2[k]);
                y[k] = pk2(mlo * silu(bflo(z[k])), mhi * silu(bfhi(z[k]))); }
            *(u32x4*)(Y + row * BRA + c * 8) = y; }
    }
    SEAM(3);
    if (IN(4)) {
        pg8::Gemm g{Y, WoA, MT, DM, BRA}; pg8::StaticOrder S; S.init(MT, DM, G, cb); pg8::EpiH1 E{a.x, a.out, H1B, SSQ};
        pg8::gemm_phase<pg8::EpiH1, pg8::StaticOrder, true, true>(lds, g, S, E);
    }
    SEAM(4);
    if (IN(5)) {
        pg8::Gemm g{H1B, WinB, MT, INB, DM}; pg8::StaticOrder S; S.init(MT, INB, G, cb); pg8::EpiProj1 E{PROJ, INB, SSQ};
        pg8::gemm_phase<pg8::EpiProj1, pg8::StaticOrder, true, true>(lds, g, S, E);
    }
    SEAM(5);
    if (IN(6)) {
        for (int u = cb; u < 512; u += G) mem_attn_unit(u, PROJ, INB, 3072, 3328 + 1024, KV + (size_t)MEMROWS * KVW, Y, BRB, 1024, lds, tid, wave, fr, fq);
        for (size_t it = gt; it < (size_t)(MT / 16) * 128; it += NGT) { const size_t t0 = (it >> 7) * 16; const int c = (int)(it & 127);
            const f32x4* cw = (const f32x4*)(a.conv_w + c * 8);
            const f32x4 w0a = cw[0], w0b = cw[1], w1a = cw[256], w1b = cw[257], w2a = cw[512], w2b = cw[513];
            float w0[8] = {w0a[0], w0a[1], w0a[2], w0a[3], w0b[0], w0b[1], w0b[2], w0b[3]}, w1[8] = {w1a[0], w1a[1], w1a[2], w1a[3], w1b[0], w1b[1], w1b[2], w1b[3]},
                  w2[8] = {w2a[0], w2a[1], w2a[2], w2a[3], w2b[0], w2b[1], w2b[2], w2b[3]};
            float am2[8], am1[8];
            if ((t0 & (SEQ - 1)) == 0) {
#pragma unroll
                for (int k = 0; k < 8; ++k) { am2[k] = 0.f; am1[k] = 0.f; }
            } else { const bf16* p2 = PROJ + (t0 - 2) * INB + c * 8; const bf16* p1 = PROJ + (t0 - 1) * INB + c * 8;
                const u32x4 c2 = *(const u32x4*)(p2 + 1024), u2 = *(const u32x4*)(p2 + 2048), c1 = *(const u32x4*)(p1 + 1024), u1 = *(const u32x4*)(p1 + 2048);
#pragma unroll
                for (int k = 0; k < 4; ++k) { am2[2 * k] = bflo(c2[k]) * bflo(u2[k]); am2[2 * k + 1] = bfhi(c2[k]) * bfhi(u2[k]); am1[2 * k] = bflo(c1[k]) * bflo(u1[k]); am1[2 * k + 1] = bfhi(c1[k]) * bfhi(u1[k]); } }
#pragma unroll 4
            for (int tt = 0; tt < 16; ++tt) { const bf16* p = PROJ + (t0 + tt) * INB + c * 8;
                const u32x4 bg = *(const u32x4*)p, cg_ = *(const u32x4*)(p + 1024), uu = *(const u32x4*)(p + 2048), zz = *(const u32x4*)(p + 3328);
                float a0[8], yv[8];
#pragma unroll
                for (int k = 0; k < 4; ++k) { a0[2 * k] = bflo(cg_[k]) * bflo(uu[k]); a0[2 * k + 1] = bfhi(cg_[k]) * bfhi(uu[k]); }
#pragma unroll
                for (int k = 0; k < 8; ++k) { const float cv = w0[k] * am2[k] + w1[k] * am1[k] + w2[k] * a0[k]; const unsigned bw = bg[k >> 1], zw = zz[k >> 1];
                    const float bgv = (k & 1) ? bfhi(bw) : bflo(bw), zv = (k & 1) ? bfhi(zw) : bflo(zw); yv[k] = bgv * cv * silu(zv); am2[k] = am1[k]; am1[k] = a0[k]; }
                u32x4 y; y.x = pk2(yv[0], yv[1]); y.y = pk2(yv[2], yv[3]); y.z = pk2(yv[4], yv[5]); y.w = pk2(yv[6], yv[7]);
                *(u32x4*)(Y + (t0 + tt) * BRB + c * 8) = y; } }
    }
    SEAM(6);
    if (IN(7)) {
        pg8::Gemm g{Y, WoB, MT, DM, BRB}; pg8::StaticOrder S; S.init(MT, DM, G, cb); pg8::EpiH2 E{a.out};
        pg8::gemm_phase<pg8::EpiH2, pg8::StaticOrder, true, true>(lds, g, S, E);
    }
    SEAM(7);
    if (IN(8)) {
        for (int m = gw; m < MT; m += NGW) { f32x4* xr = (f32x4*)(a.out + (size_t)m * DM) + lane; const f32x4* gr = (const f32x4*)a.final_g + lane;
            f32x4 v[4]; float s = 0.f;
#pragma unroll
            for (int j = 0; j < 4; ++j) { v[j] = xr[64 * j]; s += (v[j].x * v[j].x + v[j].y * v[j].y) + (v[j].z * v[j].z + v[j].w * v[j].w); }
            const float r = 1.0f / sqrtf(wave_sum(s) * (1.f / DM) + RMS_EPS);
#pragma unroll
            for (int j = 0; j < 4; ++j) xr[64 * j] = v[j] * r * gr[64 * j]; }
    }
#undef IN
#undef SEAM
}

constexpr int N_PHASES = 9;
extern "C" void kernel_launch(void* const* d_in, const int* in_sizes, int n_in, void* d_out, int out_size, void* d_ws, size_t ws_size, hipStream_t stream) {
    static int grid = 0;
    if (grid == 0) {
        int dev = 0, cus = 0, per_cu = 0;
        hipGetDevice(&dev); hipDeviceGetAttribute(&cus, hipDeviceAttributeMultiprocessorCount, dev);
        if (hipFuncSetAttribute((const void*)fwd_megakernel, hipFuncAttributeMaxDynamicSharedMemorySize, LDS_BYTES) != hipSuccess) fprintf(stderr, "kernel_launch: hipFuncSetAttribute failed\n");
        if (hipOccupancyMaxActiveBlocksPerMultiprocessor(&per_cu, (const void*)fwd_megakernel, NTHR, LDS_BYTES) != hipSuccess || per_cu < 1) { fprintf(stderr, "kernel_launch: occupancy query gave %d\n", per_cu); per_cu = 1; }
        (void)hipGetLastError();
        grid = cus * 1;
        if (ws_size < WS_END) { fprintf(stderr, "kernel_launch: workspace too small (%zu)\n", ws_size); grid = -1; }
    }
    if (grid < 0) return;
    Args a{};
    a.x = (const float*)d_in[0]; a.mem = (const float*)d_in[1]; a.pos = (const int*)d_in[2]; a.norm_g = (const float*)d_in[3]; a.mem_norm_g = (const float*)d_in[4];
    a.w_mem_kv = (const float*)d_in[5]; a.attn_w_in = (const float*)d_in[6]; a.attn_w_out = (const float*)d_in[7]; a.conv_w_in = (const float*)d_in[8];
    a.conv_w = (const float*)d_in[9]; a.conv_w_out = (const float*)d_in[10]; a.final_g = (const float*)d_in[11]; a.out = (float*)d_out; a.ws = (unsigned char*)d_ws;
#if MK_PER_PHASE
    for (int p = 0; p < N_PHASES; ++p) { a.ph_lo = p; a.ph_hi = p + 1; hipLaunchKernelGGL(fwd_megakernel, dim3(grid), dim3(NTHR), LDS_BYTES, stream, a); }
#else
    a.ph_lo = 0; a.ph_hi = N_PHASES;
    void* args[] = {&a};
    hipError_t e = hipLaunchCooperativeKernel((const void*)fwd_megakernel, dim3(grid), dim3(NTHR), args, LDS_BYTES, stream);
    if (e != hipSuccess) fprintf(stderr, "kernel_launch: cooperative launch failed: %s (grid %d)\n", hipGetErrorString(e), grid);
#endif
}
```

```cpp
#include <hip/hip_runtime.h>
#include <hip/hip_cooperative_groups.h>
#include <cstdio>
#include <cstdint>
namespace cg = cooperative_groups;
#ifndef MK_PER_PHASE
#define MK_PER_PHASE 0
#endif
#define PROBE_PH (-1)
#define PROBE_SYNC 0
#define REPS(k) ((k) == PROBE_PH ? 2 : 1)
namespace pg8 {
#define PG8_LAS __attribute__((address_space(3)))
typedef unsigned short bf16_t;
typedef short bf16x8 __attribute__((ext_vector_type(8)));
typedef float f32x4 __attribute__((ext_vector_type(4)));
typedef unsigned u32x4 __attribute__((ext_vector_type(4)));
constexpr int BM = 256, BK = 64, HALF = 128, HTB = HALF * BK * 2  , STAGE_BYTES = 8 * HTB, NXCD = 8, WGM = 8;

__host__ __device__ __forceinline__ int lds_byte(int r, int c) { const int st = (r >> 4) * 2 + (c >> 5), rr = r & 15, cc = c & 31, ob = rr * 64 + cc * 2; return st * 1024 + (ob ^ (((ob >> 9) & 1) << 5)); }
__host__ __device__ __forceinline__ void stage_rc(int b, int& R, int& C) { const int st = b / 1024, sb = b % 1024, swz = sb ^ (((sb >> 9) & 1) << 5); R = (st >> 1) * 16 + swz / 64; C = (st & 1) * 32 + (swz % 64) / 2; }
__host__ __device__ __forceinline__ int perm32(int rho) { const int n = rho >> 4, i = rho & 15; return 8 * (i >> 2) + 4 * n + (i & 3); }

struct Unit { int pm, pn; };
struct Gemm { const bf16_t* A; const bf16_t* Bt; int M, N, K; };

struct StaticOrder {
    int nM, nN, nwg, G, c;
    __host__ __device__ void init(int M, int N, int G_, int c_) { nM = M / BM; nN = N / BM; nwg = nM * nN; G = G_; c = c_; }
    __host__ __device__ bool next(int i, Unit& u) const {
        const long L = (long)i * G + c; if (L >= nwg) return false;
        int wgid = (int)L; { const int q = nwg / NXCD, r = nwg % NXCD, xcd = wgid % NXCD, off = wgid / NXCD; wgid = (xcd < r ? xcd * (q + 1) : r * (q + 1) + (xcd - r) * q) + off; }
        const int nig = WGM * nN, gid = wgid / nig, fm = gid * WGM, gsz = (nM - fm) < WGM ? (nM - fm) : WGM;
        u.pm = fm + ((wgid % nig) % gsz); u.pn = (wgid % nig) / gsz; return true;
    }
    __device__ __forceinline__ void a_ready(const Unit&) const {}
    __device__ __forceinline__ void done(const Unit&) const {}
};
__device__ __forceinline__ unsigned cvt_pk_bf16(float lo, float hi) { unsigned r; asm volatile("v_cvt_pk_bf16_f32 %0, %1, %2" : "=v"(r) : "v"(lo), "v"(hi)); return r; }
typedef float f32x2 __attribute__((ext_vector_type(2)));
constexpr float QK_C2 = 0.125f * 1.4426950408889634f;
struct EpiPlain {
    static constexpr bool PERM = true, AFTER_DRAIN = false;
    bf16_t* O; int ldc;
    __device__ __forceinline__ void operator()(f32x4 (&acc)[2][2][4][2], const Unit& u, int wr, int wc, int fr, int fq) const {
        const int row0 = u.pm * BM + wr * 64 + fr, col0 = u.pn * BM + wc * 32 + 8 * fq;
#pragma unroll
        for (int ai = 0; ai < 2; ++ai)
#pragma unroll
            for (int m = 0; m < 4; ++m) { bf16_t* rowp = O + (size_t)(row0 + ai * HALF + m * 16) * ldc + col0;
#pragma unroll
                for (int bj = 0; bj < 2; ++bj) { const f32x4 v0 = acc[ai][bj][m][0], v1 = acc[ai][bj][m][1];
                    u32x4 w; w.x = cvt_pk_bf16(v0[0], v0[1]); w.y = cvt_pk_bf16(v0[2], v0[3]); w.z = cvt_pk_bf16(v1[0], v1[1]); w.w = cvt_pk_bf16(v1[2], v1[3]);
                    *(u32x4*)(rowp + bj * HALF) = w; } }
    }
};
struct EpiProj0 {
    static constexpr bool PERM = true, AFTER_DRAIN = false;
    bf16_t* O; int ldc; const float* rope;
    __device__ __forceinline__ void operator()(f32x4 (&acc)[2][2][4][2], const Unit& u, int wr, int wc, int fr, int fq) const {
        const int pn = u.pn, row0 = u.pm * BM + wr * 64 + fr, col0 = pn * BM + wc * 32 + 8 * fq;
        if (pn < 12 && (wc & 1) == 0) {
            const float sgn = fq == 0 ? -1.f : 1.f; const bool act = fq < 2;
#pragma unroll
            for (int ai = 0; ai < 2; ++ai)
#pragma unroll
                for (int m = 0; m < 4; ++m) { const f32x4* rp = (const f32x4*)(rope + (size_t)(row0 + ai * HALF + m * 16) * 16);
                    const f32x4 c0 = rp[0], c1 = rp[1], s0 = rp[2], s1 = rp[3];
#pragma unroll
                    for (int bj = 0; bj < 2; ++bj) { const f32x4 v0 = acc[ai][bj][m][0], v1 = acc[ai][bj][m][1]; f32x4 p0, p1;
#pragma unroll
                        for (int k = 0; k < 4; ++k) { p0[k] = __shfl_xor(v0[k], 16); p1[k] = __shfl_xor(v1[k], 16); }
                        if (act) { acc[ai][bj][m][0] = v0 * c0 + (p0 * s0) * sgn; acc[ai][bj][m][1] = v1 * c1 + (p1 * s1) * sgn; } } }
        }
        const float sc = (pn < 6 || pn == 18) ? QK_C2 : 1.f;
#pragma unroll
        for (int ai = 0; ai < 2; ++ai)
#pragma unroll
            for (int m = 0; m < 4; ++m) { bf16_t* rowp = O + (size_t)(row0 + ai * HALF + m * 16) * ldc + col0;
#pragma unroll
                for (int bj = 0; bj < 2; ++bj) { const f32x4 v0 = acc[ai][bj][m][0] * sc, v1 = acc[ai][bj][m][1] * sc;
                    u32x4 w; w.x = cvt_pk_bf16(v0[0], v0[1]); w.y = cvt_pk_bf16(v0[2], v0[3]); w.z = cvt_pk_bf16(v1[0], v1[1]); w.w = cvt_pk_bf16(v1[2], v1[3]);
                    *(u32x4*)(rowp + bj * HALF) = w; } }
    }
};
struct EpiH1 {
    static constexpr bool PERM = true, AFTER_DRAIN = false;
    const float* x; float* h1; bf16_t* h1b; float* ssq;
    __device__ __forceinline__ void operator()(f32x4 (&acc)[2][2][4][2], const Unit& u, int wr, int wc, int fr, int fq) const {
        const int row0 = u.pm * BM + wr * 64 + fr, col0 = u.pn * BM + wc * 32 + 8 * fq;
#pragma unroll
        for (int ai = 0; ai < 2; ++ai)
#pragma unroll
            for (int m = 0; m < 4; ++m) { const int row = row0 + ai * HALF + m * 16; const size_t off = (size_t)row * 1024 + col0; float ss = 0.f;
#pragma unroll
                for (int bj = 0; bj < 2; ++bj) { const f32x4 x0 = *(const f32x4*)(x + off + bj * HALF), x1 = *(const f32x4*)(x + off + bj * HALF + 4);
                    const f32x4 v0 = acc[ai][bj][m][0] + x0, v1 = acc[ai][bj][m][1] + x1;
                    *(f32x4*)(h1 + off + bj * HALF) = v0; *(f32x4*)(h1 + off + bj * HALF + 4) = v1;
                    u32x4 w; w.x = cvt_pk_bf16(v0[0], v0[1]); w.y = cvt_pk_bf16(v0[2], v0[3]); w.z = cvt_pk_bf16(v1[0], v1[1]); w.w = cvt_pk_bf16(v1[2], v1[3]);
                    *(u32x4*)(h1b + off + bj * HALF) = w;
                    ss += (v0[0] * v0[0] + v0[1] * v0[1]) + (v0[2] * v0[2] + v0[3] * v0[3]) + (v1[0] * v1[0] + v1[1] * v1[1]) + (v1[2] * v1[2] + v1[3] * v1[3]); }
                ss += __shfl_xor(ss, 16); ss += __shfl_xor(ss, 32);
                if (fq == 0) ssq[(size_t)row * 16 + u.pn * 4 + wc] = ss; }
    }
};
struct EpiProj1 {
    static constexpr bool PERM = true, AFTER_DRAIN = false;
    bf16_t* O; int ldc; const float* ssq;
    __device__ __forceinline__ void operator()(f32x4 (&acc)[2][2][4][2], const Unit& u, int wr, int wc, int fr, int fq) const {
        const int row0 = u.pm * BM + wr * 64 + fr, col0 = u.pn * BM + wc * 32 + 8 * fq; const float sc = (u.pn == 12) ? QK_C2 : 1.f;
#pragma unroll
        for (int ai = 0; ai < 2; ++ai)
#pragma unroll
            for (int m = 0; m < 4; ++m) { const int row = row0 + ai * HALF + m * 16; const f32x4* sp = (const f32x4*)(ssq + (size_t)row * 16);
                const f32x4 a = sp[0], b = sp[1], c = sp[2], d = sp[3];
                const float tot = ((a[0] + a[1]) + (a[2] + a[3])) + ((b[0] + b[1]) + (b[2] + b[3])) + ((c[0] + c[1]) + (c[2] + c[3])) + ((d[0] + d[1]) + (d[2] + d[3]));
                const float r = sc / sqrtf(tot * (1.0f / 1024.0f) + 1e-6f);
                bf16_t* rowp = O + (size_t)row * ldc + col0;
#pragma unroll
                for (int bj = 0; bj < 2; ++bj) { const f32x4 v0 = acc[ai][bj][m][0] * r, v1 = acc[ai][bj][m][1] * r;
                    u32x4 w; w.x = cvt_pk_bf16(v0[0], v0[1]); w.y = cvt_pk_bf16(v0[2], v0[3]); w.z = cvt_pk_bf16(v1[0], v1[1]); w.w = cvt_pk_bf16(v1[2], v1[3]);
                    *(u32x4*)(rowp + bj * HALF) = w; } }
    }
};
struct EpiH2 {
    static constexpr bool PERM = true, AFTER_DRAIN = false;
    const float* h; float* ho;
    __device__ __forceinline__ void operator()(f32x4 (&acc)[2][2][4][2], const Unit& u, int wr, int wc, int fr, int fq) const {
        const int row0 = u.pm * BM + wr * 64 + fr, col0 = u.pn * BM + wc * 32 + 8 * fq;
#pragma unroll
        for (int ai = 0; ai < 2; ++ai)
#pragma unroll
            for (int m = 0; m < 4; ++m) { const size_t off = (size_t)(row0 + ai * HALF + m * 16) * 1024 + col0;
#pragma unroll
                for (int bj = 0; bj < 2; ++bj) { const f32x4 x0 = *(const f32x4*)(h + off + bj * HALF), x1 = *(const f32x4*)(h + off + bj * HALF + 4);
                    *(f32x4*)(ho + off + bj * HALF) = acc[ai][bj][m][0] + x0; *(f32x4*)(ho + off + bj * HALF + 4) = acc[ai][bj][m][1] + x1; } }
    }
};

template <class Epi, class Sched, bool ALIGN_EPI = false, bool SP2 = false>
__device__ __forceinline__ void gemm_phase(PG8_LAS unsigned char* lds, const Gemm g, const Sched& S, const Epi& E) {
    const int tid = threadIdx.x, wid = __builtin_amdgcn_readfirstlane(tid >> 6), lane = tid & 63, wr = wid >> 2, wc = wid & 3, fr = lane & 15, fq = lane >> 4;
    const int K = g.K, nt = K / BK;
    unsigned voffA[2], voffB[2];
#pragma unroll
    for (int i = 0; i < 2; ++i) { int R, C; stage_rc(tid * 16 + i * 8192, R, C); const int Rb = Epi::PERM ? ((R & ~31) + perm32(R & 31)) : R;
        voffA[i] = (unsigned)(R * K + C) * 2u; voffB[i] = (unsigned)(Rb * K + C) * 2u; }
    const size_t kstep = (size_t)(BK * 2);
    const size_t hstep = (size_t)HALF * K * 2;
    const size_t tstep = 2 * hstep;
    const unsigned ldsw = (unsigned)wid * 1024u;
    const int aoff = lds_byte(wr * 64 + fr, fq * 8), boff = lds_byte(wc * 32 + fr, fq * 8);
#define PG8_SA(b, h) (((b) * 2 + (h)) * HTB)
#define PG8_SB(b, h) ((4 + (b) * 2 + (h)) * HTB)
#define PG8_STAGE(bufoff, gbase, voff) do { _Pragma("unroll") for (int _i = 0; _i < 2; ++_i) \
        __builtin_amdgcn_global_load_lds((const unsigned*)((const char*)(gbase) + (voff)[_i]), (PG8_LAS unsigned*)(lds + (bufoff) + ldsw + _i * 8192), 16, 0, 0); } while (0)
#define PG8_LDA(dst, b, h) do { _Pragma("unroll") for (int m = 0; m < 4; ++m) _Pragma("unroll") for (int k = 0; k < 2; ++k) dst[m][k] = *(const PG8_LAS bf16x8*)(lds + PG8_SA(b, h) + aoff + m * 2048 + k * 1024); } while (0)
#define PG8_LDB(dst, b, h) do { _Pragma("unroll") for (int n = 0; n < 2; ++n) _Pragma("unroll") for (int k = 0; k < 2; ++k) dst[n][k] = *(const PG8_LAS bf16x8*)(lds + PG8_SB(b, h) + boff + n * 2048 + k * 1024); } while (0)
#define PG8_MMA(ai, bj, At, Bt) do { __builtin_amdgcn_s_setprio(1); _Pragma("unroll") for (int m = 0; m < 4; ++m) _Pragma("unroll") for (int n = 0; n < 2; ++n) _Pragma("unroll") for (int k = 0; k < 2; ++k) \
        acc[ai][bj][m][n] = __builtin_amdgcn_mfma_f32_16x16x32_bf16(Bt[n][k], At[m][k], acc[ai][bj][m][n], 0, 0, 0); __builtin_amdgcn_s_setprio(0); } while (0)
#define PG8_WAIT_V(n) asm volatile("s_waitcnt vmcnt(" #n ")" ::: "memory")
#define PG8_WAIT_L(n) asm volatile("s_waitcnt lgkmcnt(" #n ")" ::: "memory")
#define PG8_BAR __builtin_amdgcn_s_barrier()
#define PG8_SCHED __builtin_amdgcn_sched_barrier(0)
    Unit cur, nxt; int ui = 0;
    if (!S.next(0, cur)) return;
    f32x4 acc[2][2][4][2];
#pragma unroll
    for (int a = 0; a < 2; ++a)
#pragma unroll
        for (int b = 0; b < 2; ++b)
#pragma unroll
            for (int m = 0; m < 4; ++m)
#pragma unroll
                for (int n = 0; n < 2; ++n) acc[a][b][m][n] = (f32x4){0.f, 0.f, 0.f, 0.f};
    bf16x8 At[4][2], B0[2][2], B1[2][2];
    const char* cA = (const char*)g.A + (size_t)cur.pm * tstep; const char* cB = (const char*)g.Bt + (size_t)cur.pn * tstep;
    S.a_ready(cur);
    if constexpr (SP2) {
        PG8_STAGE(PG8_SB(0, 0), cB, voffB); PG8_STAGE(PG8_SB(0, 1), cB + hstep, voffB); PG8_STAGE(PG8_SA(0, 0), cA, voffA); PG8_STAGE(PG8_SA(0, 1), cA + hstep, voffA);
        if (wr == 1) PG8_BAR;
        PG8_WAIT_V(2); PG8_BAR;
        PG8_STAGE(PG8_SB(1, 0), cB + kstep, voffB); PG8_STAGE(PG8_SA(1, 0), cA + kstep, voffA); PG8_STAGE(PG8_SB(1, 1), cB + hstep + kstep, voffB);
        PG8_WAIT_V(6); PG8_BAR;
    } else {
        PG8_STAGE(PG8_SB(0, 0), cB, voffB); PG8_STAGE(PG8_SA(0, 0), cA, voffA); PG8_STAGE(PG8_SB(0, 1), cB + hstep, voffB); PG8_STAGE(PG8_SA(0, 1), cA + hstep, voffA);
        if (wr == 1) PG8_BAR;
        PG8_WAIT_V(4); PG8_BAR;
        PG8_STAGE(PG8_SB(1, 0), cB + kstep, voffB); PG8_STAGE(PG8_SA(1, 0), cA + kstep, voffA); PG8_STAGE(PG8_SB(1, 1), cB + hstep + kstep, voffB);
        PG8_WAIT_V(6); PG8_BAR;
    }
    for (;;) {
        const bool has_next = S.next(ui + 1, nxt);
        const char* nA = has_next ? (const char*)g.A + (size_t)nxt.pm * tstep : cA; const char* nB = has_next ? (const char*)g.Bt + (size_t)nxt.pn * tstep : cB;
        for (int t = 0; t < nt; t += 2) {
            const bool last = (t == nt - 2);
            const char* a1 = cA + (size_t)(t + 1) * kstep;
            const char* a2 = last ? nA : cA + (size_t)(t + 2) * kstep; const char* b2 = last ? nB : cB + (size_t)(t + 2) * kstep;
            const char* a3 = a2 + kstep; const char* b3 = b2 + kstep;
            if (last && has_next) S.a_ready(nxt);
            if constexpr (SP2) {
            PG8_LDB(B0, 0, 0); PG8_LDB(B1, 0, 1); PG8_SCHED; PG8_LDA(At, 0, 0); PG8_STAGE(PG8_SA(1, 1), a1 + hstep, voffA);
            PG8_WAIT_V(8); PG8_WAIT_L(0); PG8_BAR; PG8_MMA(0, 0, At, B0); PG8_MMA(0, 1, At, B1); PG8_BAR; PG8_SCHED;
            PG8_LDA(At, 0, 1); PG8_STAGE(PG8_SB(0, 0), b2, voffB); PG8_STAGE(PG8_SB(0, 1), b2 + hstep, voffB); PG8_STAGE(PG8_SA(0, 0), a2, voffA);
            PG8_WAIT_V(8); PG8_WAIT_L(0); PG8_BAR; PG8_MMA(1, 0, At, B0); PG8_MMA(1, 1, At, B1); PG8_BAR; PG8_SCHED;
            PG8_LDB(B0, 1, 0); PG8_LDB(B1, 1, 1); PG8_SCHED; PG8_LDA(At, 1, 0); PG8_STAGE(PG8_SA(0, 1), a2 + hstep, voffA);
            PG8_WAIT_V(8); PG8_WAIT_L(0); PG8_BAR; PG8_MMA(0, 0, At, B0); PG8_MMA(0, 1, At, B1); PG8_BAR; PG8_SCHED;
            PG8_LDA(At, 1, 1); PG8_STAGE(PG8_SB(1, 0), b3, voffB); PG8_STAGE(PG8_SB(1, 1), b3 + hstep, voffB); PG8_STAGE(PG8_SA(1, 0), a3, voffA);
            PG8_WAIT_V(8); PG8_WAIT_L(0); PG8_BAR; PG8_MMA(1, 0, At, B0); PG8_MMA(1, 1, At, B1); PG8_BAR; PG8_SCHED;
            } else {
            PG8_LDB(B0, 0, 0); PG8_SCHED; PG8_LDA(At, 0, 0); PG8_STAGE(PG8_SA(1, 1), a1 + hstep, voffA);
            PG8_WAIT_L(8); PG8_BAR; PG8_WAIT_L(0); PG8_MMA(0, 0, At, B0); PG8_BAR; PG8_SCHED;
            PG8_LDB(B1, 0, 1); PG8_STAGE(PG8_SB(0, 0), b2, voffB);
            PG8_BAR; PG8_WAIT_L(0); PG8_MMA(0, 1, At, B1); PG8_BAR;
            PG8_LDA(At, 0, 1); PG8_STAGE(PG8_SA(0, 0), a2, voffA);
            PG8_BAR; PG8_WAIT_L(0); PG8_MMA(1, 0, At, B0); PG8_BAR; PG8_SCHED;
            PG8_STAGE(PG8_SB(0, 1), b2 + hstep, voffB);
            PG8_WAIT_V(6); PG8_BAR; PG8_MMA(1, 1, At, B1); PG8_BAR;
            PG8_LDB(B0, 1, 0); PG8_SCHED; PG8_LDA(At, 1, 0); PG8_STAGE(PG8_SA(0, 1), a2 + hstep, voffA);
            PG8_WAIT_L(8); PG8_BAR; PG8_WAIT_L(0); PG8_MMA(0, 0, At, B0); PG8_BAR; PG8_SCHED;
            PG8_LDB(B1, 1, 1); PG8_STAGE(PG8_SB(1, 0), b3, voffB);
            PG8_BAR; PG8_WAIT_L(0); PG8_MMA(0, 1, At, B1); PG8_BAR;
            PG8_LDA(At, 1, 1); PG8_STAGE(PG8_SA(1, 0), a3, voffA);
            PG8_BAR; PG8_WAIT_L(0); PG8_MMA(1, 0, At, B0); PG8_BAR; PG8_SCHED;
            PG8_STAGE(PG8_SB(1, 1), b3 + hstep, voffB);
            PG8_WAIT_V(6); PG8_BAR; PG8_MMA(1, 1, At, B1); PG8_BAR;
            }
        }
        if constexpr (ALIGN_EPI) { if (wr == 0) PG8_BAR; }
        if constexpr (!Epi::AFTER_DRAIN) { E(acc, cur, wr, wc, fr, fq); S.done(cur); }
        if (!has_next) break;
#pragma unroll
        for (int a = 0; a < 2; ++a)
#pragma unroll
            for (int b = 0; b < 2; ++b)
#pragma unroll
                for (int m = 0; m < 4; ++m)
#pragma unroll
                    for (int n = 0; n < 2; ++n) acc[a][b][m][n] = (f32x4){0.f, 0.f, 0.f, 0.f};
        cur = nxt; cA = nA; cB = nB; ++ui;
        if constexpr (ALIGN_EPI) { if (wr == 1) PG8_BAR; }
    }
    PG8_WAIT_V(0);
    if constexpr (!ALIGN_EPI) { if (wr == 0) PG8_BAR; }
    PG8_BAR;
    if constexpr (Epi::AFTER_DRAIN) { E.fused(acc, cur, wr, wc, fr, fq, lds, wid, lane); S.done(cur); }
#undef PG8_SA
#undef PG8_SB
#undef PG8_STAGE
#undef PG8_LDA
#undef PG8_LDB
#undef PG8_MMA
#undef PG8_WAIT_V
#undef PG8_WAIT_L
#undef PG8_BAR
#undef PG8_SCHED
}
}
constexpr int NB = 8, SEQ = 2048, DM = 1024, MT = NB * SEQ;
constexpr int INA = 5632, INB = 4608, BRA = 768, BRB = 1280, NMEM = 256, MEMROWS = NB * NMEM, KVW = 512;
constexpr float RMS_EPS = 1e-6f;
constexpr size_t MiB = 1u << 20;
constexpr size_t WS_WINA = 1 * MiB, WS_WINB = 12 * MiB, WS_WOA = 21 * MiB, WS_WOB = 23 * MiB, WS_WKV = 26 * MiB;
constexpr size_t WS_KV = 28 * MiB;
constexpr size_t WS_LSE = 32 * MiB;
constexpr size_t WS_ROPE = 34 * MiB;
constexpr size_t WS_SSQ = 35 * MiB;
constexpr size_t WS_HN = 36 * MiB;
constexpr size_t WS_MEMN = 68 * MiB;
constexpr size_t WS_PROJ = 76 * MiB;
constexpr size_t WS_H1B = 220 * MiB;
constexpr size_t WS_END = 252 * MiB;
static_assert(WS_PROJ + (size_t)MT * INA * 2 <= WS_END && WS_PROJ + (size_t)MT * INB * 2 <= WS_H1B && WS_HN + (size_t)MT * BRB * 2 <= WS_PROJ, "d_ws map");

#define LAS __attribute__((address_space(3)))
typedef unsigned short bf16;
typedef unsigned u32x4 __attribute__((ext_vector_type(4)));
typedef unsigned u32x2 __attribute__((ext_vector_type(2)));
typedef float f32x4 __attribute__((ext_vector_type(4)));
typedef short bf16x8 __attribute__((ext_vector_type(8)));
constexpr int NTHR = 512, NWAVES = 8;
constexpr int LDS_BYTES = 147456;
constexpr int MISC_OFF = 131072 + 320;
constexpr size_t WS_CTL = 0, CTL_ZERO_BYTES = 65536;
constexpr int CW_BAR = 1024;

__device__ __forceinline__ unsigned f2bf(float f) { unsigned u = __builtin_bit_cast(unsigned, f); return (u + 0x7fffu + ((u >> 16) & 1u)) >> 16; }
__device__ __forceinline__ unsigned pk2(float lo, float hi) { return f2bf(lo) | (f2bf(hi) << 16); }
__device__ __forceinline__ float bflo(unsigned w) { return __builtin_bit_cast(float, w << 16); }
__device__ __forceinline__ float bfhi(unsigned w) { return __builtin_bit_cast(float, w & 0xffff0000u); }
__device__ __forceinline__ float wave_sum(float v) {
#pragma unroll
    for (int o = 1; o < 64; o <<= 1) v += __shfl_xor(v, o);
    return v;
}
__device__ __forceinline__ float silu(float z) { return z / (1.0f + __expf(-z)); }

__device__ __forceinline__ void p0_transpose_item(const float* W, int K, int N, bf16* WT, const float* g, LAS float* scr, int item, int lane) {
    const int nblk = N / 32, kb = item / nblk, nb = item % nblk, k0 = 64 * kb, n0 = 32 * nb;
#pragma unroll 8
    for (int i = 0; i < 32; ++i) { const int kk = 2 * i + (lane >> 5); float v = W[(size_t)(k0 + kk) * N + n0 + (lane & 31)]; if (g) v *= g[k0 + kk]; scr[kk * 33 + (lane & 31)] = v; }
    asm volatile("s_waitcnt lgkmcnt(0)" ::: "memory");
    const int c = lane & 7;
#pragma unroll
    for (int j = 0; j < 4; ++j) { const int n = (lane >> 3) + 8 * j; const LAS float* s = scr + (8 * c) * 33 + n;
        u32x4 o; o.x = pk2(s[0 * 33], s[1 * 33]); o.y = pk2(s[2 * 33], s[3 * 33]); o.z = pk2(s[4 * 33], s[5 * 33]); o.w = pk2(s[6 * 33], s[7 * 33]);
        *(u32x4*)(WT + (size_t)(n0 + n) * K + k0 + 8 * c) = o; }
    asm volatile("s_waitcnt lgkmcnt(0)" ::: "memory");
}
__device__ __forceinline__ void rms_row_to_bf16(const float* xrow, const float* g, bf16* orow, int lane) {
    const f32x4* xr = (const f32x4*)xrow + lane; const f32x4* gr = (const f32x4*)g + lane;
    f32x4 v[4]; float s = 0.f;
#pragma unroll
    for (int j = 0; j < 4; ++j) { v[j] = xr[64 * j]; s += (v[j].x * v[j].x + v[j].y * v[j].y) + (v[j].z * v[j].z + v[j].w * v[j].w); }
    const float r = 1.0f / sqrtf(wave_sum(s) * (1.f / DM) + RMS_EPS);
    unsigned long long* o8 = (unsigned long long*)orow + lane;
#pragma unroll
    for (int j = 0; j < 4; ++j) { const f32x4 gg = gr[64 * j]; o8[64 * j] = (unsigned long long)pk2(v[j].x * r * gg.x, v[j].y * r * gg.y) | ((unsigned long long)pk2(v[j].z * r * gg.z, v[j].w * r * gg.w) << 32); }
}

constexpr int KROWB = 144, VROWB = 544, LDS_KOFF = 0, LDS_VOFF = 256 * KROWB, ATT_LDS = LDS_VOFF + 64 * VROWB;
template <bool WIN>
__device__ __forceinline__ void attn_core(const LAS unsigned char* Kl, const LAS unsigned char* Vl, int q0, bf16x8 qf0, bf16x8 qf1, bool firstblk, int wave, int fr, int fq, f32x4 (&o)[4], float& lse2) {
    constexpr int NT = WIN ? 9 : 16, NK = WIN ? 5 : 8;
    const int kb0 = WIN ? q0 : 0;
    f32x4 s[NT];
#pragma unroll
    for (int t = 0; t < NT; ++t) {
        const LAS unsigned char* kp = Kl + (kb0 + 16 * t + fr) * KROWB + fq * 16;
        const bf16x8 a0 = *(const LAS bf16x8*)kp, a1 = *(const LAS bf16x8*)(kp + 64);
        f32x4 z = (f32x4){0.f, 0.f, 0.f, 0.f};
        z = __builtin_amdgcn_mfma_f32_16x16x32_bf16(a0, qf0, z, 0, 0, 0);
        s[t] = __builtin_amdgcn_mfma_f32_16x16x32_bf16(a1, qf1, z, 0, 0, 0);
    }
    if (WIN) {
        const int dd = fr - 4 * fq; const float NEG = -INFINITY;
#pragma unroll
        for (int i = 0; i < 4; ++i) { if (dd - i > 0) s[0][i] = NEG; if (dd - i < 0) s[NT - 1][i] = NEG; }
        if (firstblk) {
#pragma unroll
            for (int t = 0; t < NT - 1; ++t) if (wave + t < 8) s[t] = (f32x4){NEG, NEG, NEG, NEG};
        }
    }
    float m = s[0][0];
#pragma unroll
    for (int t = 0; t < NT; ++t) m = fmaxf(fmaxf(m, fmaxf(s[t][0], s[t][1])), fmaxf(s[t][2], s[t][3]));
    m = fmaxf(m, __shfl_xor(m, 16)); m = fmaxf(m, __shfl_xor(m, 32));
    float sum = 0.f;
#pragma unroll
    for (int t = 0; t < NT; ++t) {
#pragma unroll
        for (int i = 0; i < 4; ++i) { s[t][i] = __builtin_amdgcn_exp2f(s[t][i] - m); sum += s[t][i]; } }
    sum += __shfl_xor(sum, 16); sum += __shfl_xor(sum, 32);
    lse2 = m + __builtin_log2f(sum);
    bf16x8 pf[NK];
#pragma unroll
    for (int k = 0; k < NK; ++k) { u32x4 w; w.x = pg8::cvt_pk_bf16(s[2 * k][0], s[2 * k][1]); w.y = pg8::cvt_pk_bf16(s[2 * k][2], s[2 * k][3]);
        if (2 * k + 1 < NT) { w.z = pg8::cvt_pk_bf16(s[2 * k + 1][0], s[2 * k + 1][1]); w.w = pg8::cvt_pk_bf16(s[2 * k + 1][2], s[2 * k + 1][3]); } else { w.z = 0u; w.w = 0u; }
        pf[k] = __builtin_bit_cast(bf16x8, w); }
    const float inv = 1.0f / sum;
#pragma unroll
    for (int dt = 0; dt < 4; ++dt) {
        f32x4 acc = (f32x4){0.f, 0.f, 0.f, 0.f};
#pragma unroll
        for (int k = 0; k < NK; ++k) {
            const LAS unsigned char* vp = Vl + (16 * dt + fr) * VROWB + (kb0 + 32 * k + 4 * fq) * 2;
            const u32x2 lo = *(const LAS u32x2*)vp, hi = *(const LAS u32x2*)(vp + 32);
            const bf16x8 vf = __builtin_bit_cast(bf16x8, (u32x4){lo.x, lo.y, hi.x, hi.y});
            acc = __builtin_amdgcn_mfma_f32_16x16x32_bf16(vf, pf[k], acc, 0, 0, 0);
        }
        o[dt] = acc * inv;
    }
}
template <class RowOff>
__device__ __forceinline__ void attn_stage(LAS unsigned char* Kl, LAS unsigned char* Vl, const bf16* Kg, const bf16* Vg, const RowOff& rowoff, int tid) {
    u32x4 kv[4], vv[4];
#pragma unroll
    for (int i = 0; i < 4; ++i) { const int c = tid + NTHR * i, row = c >> 3, ch = c & 7; const size_t off = rowoff(row) + ch * 8;
        kv[i] = *(const u32x4*)(Kg + off); vv[i] = *(const u32x4*)(Vg + off); }
#pragma unroll
    for (int i = 0; i < 4; ++i) { const int c = tid + NTHR * i, row = c >> 3, ch = c & 7;
        *(LAS u32x4*)(Kl + row * KROWB + ch * 16) = kv[i];
#pragma unroll
        for (int j = 0; j < 8; ++j) { const unsigned w = vv[i][j >> 1]; *(LAS unsigned short*)(Vl + (ch * 8 + j) * VROWB + row * 2) = (unsigned short)((j & 1) ? (w >> 16) : (w & 0xffffu)); } }
}

#define RLX_AGENT __ATOMIC_RELAXED, __HIP_MEMORY_SCOPE_AGENT
#define XB_TMO      128
#define XB_XCNT(j)  (256  + 64 * (j))
#define XB_XSUB(j)  (1280 + 64 * (j))
#define XB_XGEN(j)  (2304 + 64 * (j))
#define XB_TOP      3328
#define XB_TOPGEN   3392
#define XCD_BAR_WORDS 3456
#define XB_SPIN_CAP (1u << 18)

__device__ __forceinline__ unsigned xb_ld(unsigned* p)              { return __hip_atomic_load(p, __ATOMIC_RELAXED, __HIP_MEMORY_SCOPE_AGENT); }
__device__ __forceinline__ unsigned xb_add(unsigned* p, unsigned v) { return __hip_atomic_fetch_add(p, v, __ATOMIC_RELAXED, __HIP_MEMORY_SCOPE_AGENT); }
__device__ __forceinline__ unsigned xb_xcc_id() { return (unsigned)__builtin_amdgcn_s_getreg((3 << 11) | 20) & 0xFu; }
#define XB_SPIN(cond, bar) do { unsigned _sp = 0; while (cond) { __builtin_amdgcn_s_sleep(1); \
    if ((++_sp & 255u) == 0u) { if (xb_ld(&(bar)[XB_TMO])) break; if (_sp > XB_SPIN_CAP) { atomicAdd(&(bar)[XB_TMO], 1u); break; } } } } while (0)

struct XcdBarrier {
    unsigned* bar; unsigned x;
    volatile LAS unsigned* st;
};

__device__ __forceinline__ XcdBarrier xcd_barrier_post(unsigned* bar, volatile LAS unsigned* st) {
    XcdBarrier b; b.bar = bar; b.x = xb_xcc_id(); b.st = st;
    if (threadIdx.x == 0) (void)xb_add(&bar[XB_XCNT(b.x)], 1u);
    return b;
}
__device__ __forceinline__ void xcd_barrier_complete(unsigned* bar, unsigned x, unsigned& nloc, unsigned& nx) {
    const unsigned G = gridDim.x * gridDim.y * gridDim.z;
    unsigned sum, cnt, mine, sp = 0u;
    for (;;) {
        sum = 0u; cnt = 0u; mine = 0u;
#pragma unroll
        for (unsigned j = 0; j < 16; ++j) { const unsigned c = xb_ld(&bar[XB_XCNT(j)]); sum += c; cnt += (c > 0u) ? 1u : 0u; mine = (j == x) ? c : mine; }
        if (sum == G) break;
        __builtin_amdgcn_s_sleep(1);
        if ((++sp & 255u) == 0u) { if (xb_ld(&bar[XB_TMO])) break; if (sp > XB_SPIN_CAP) { atomicAdd(&bar[XB_TMO], 1u); break; } }
    }
    nloc = mine > 0u ? mine : 1u; nx = cnt > 0u ? cnt : 1u;
}

__device__ __forceinline__ void xcd_barrier(const XcdBarrier& b) {
    asm volatile("s_waitcnt vmcnt(0)" ::: "memory");
    __syncthreads();
    if (threadIdx.x == 0) {
        unsigned* bar = b.bar;
        __builtin_amdgcn_s_waitcnt(0);
        unsigned nloc = b.st[0], nx = b.st[1];
        if (nloc == 0u) { xcd_barrier_complete(bar, b.x, nloc, nx); b.st[0] = nloc; b.st[1] = nx; }
        const unsigned old = xb_add(&bar[XB_XSUB(b.x)], 1u);
        const unsigned gen = old / nloc;
        if (old + 1u == (gen + 1u) * nloc) {
            __builtin_amdgcn_fence(__ATOMIC_RELEASE, "agent");
            asm volatile("s_waitcnt vmcnt(0)" ::: "memory");
            const unsigned og = xb_add(&bar[XB_TOP], 1u);
            const unsigned tg = og / nx;
            if (og + 1u == (tg + 1u) * nx) xb_add(&bar[XB_TOPGEN], 1u);
            else XB_SPIN(xb_ld(&bar[XB_TOPGEN]) == tg, bar);
            __builtin_amdgcn_fence(__ATOMIC_ACQUIRE, "agent");
            xb_add(&bar[XB_XGEN(b.x)], 1u);
            asm volatile("s_waitcnt vmcnt(0)" ::: "memory");
        } else {
            XB_SPIN(xb_ld(&bar[XB_XGEN(b.x)]) == gen, bar);
            __builtin_amdgcn_fence(__ATOMIC_ACQUIRE, "agent");
            asm volatile("s_waitcnt vmcnt(0)" ::: "memory");
        }
    }
    __syncthreads();
}

struct Args { const float* x; const float* mem; const int* pos; const float* norm_g; const float* mem_norm_g; const float* w_mem_kv; const float* attn_w_in; const float* attn_w_out;
              const float* conv_w_in; const float* conv_w; const float* conv_w_out; const float* final_g; float* out; unsigned char* ws; int ph_lo, ph_hi; };

__device__ __forceinline__ void mem_attn_unit(int u, const bf16* proj, int ldp, int qcol, int zcol, const bf16* kvb, bf16* y, int ldy, int ycol, LAS unsigned char* lds, int tid, int wave, int fr, int fq) {
    const int b = u >> 6, h = (u >> 4) & 3, qb = u & 15;
    LAS unsigned char* Kl = lds + LDS_KOFF; LAS unsigned char* Vl = lds + LDS_VOFF;
    const bf16* Kg = kvb + (size_t)b * NMEM * KVW + h * 64;
    attn_stage(Kl, Vl, Kg, Kg + 256, [](int row) { return (size_t)row * KVW; }, tid);
    const size_t row = (size_t)b * SEQ + qb * 128 + wave * 16 + fr;
    const bf16* qp = proj + row * ldp + qcol + h * 64 + 8 * fq;
    const bf16x8 qf0 = *(const bf16x8*)qp, qf1 = *(const bf16x8*)(qp + 32);
    u32x2 zr[4];
#pragma unroll
    for (int dt = 0; dt < 4; ++dt) zr[dt] = *(const u32x2*)(proj + row * ldp + zcol + h * 64 + 16 * dt + 4 * fq);
    __syncthreads();
    f32x4 o[4]; float lse2;
    attn_core<false>(Kl, Vl, 0, qf0, qf1, false, wave, fr, fq, o, lse2);
#pragma unroll
    for (int dt = 0; dt < 4; ++dt) { u32x2 w; w.x = pk2(o[dt][0] * silu(bflo(zr[dt].x)), o[dt][1] * silu(bfhi(zr[dt].x))); w.y = pk2(o[dt][2] * silu(bflo(zr[dt].y)), o[dt][3] * silu(bfhi(zr[dt].y)));
        *(u32x2*)(y + row * ldy + ycol + h * 64 + 16 * dt + 4 * fq) = w; }
    __syncthreads();
}
__device__ __forceinline__ void dil_attn_unit(int u, bf16* proj, float* lse, LAS unsigned char* lds, int tid, int wave, int fr, int fq, bool dry, bf16* dryout) {
    const int b = u / 384, rem = u % 384, hh = rem >> 4, idx = rem & 15, g = hh >> 3;
    const int dil = g == 0 ? 1 : (g == 1 ? 4 : 16), lgblk = g == 0 ? 4 : (g == 1 ? 2 : 0);
    const int r = idx >> lgblk, j = idx & ((1 << lgblk) - 1);
    LAS unsigned char* Kl = lds + LDS_KOFF; LAS unsigned char* Vl = lds + LDS_VOFF;
    const size_t base = (size_t)b * SEQ;
    attn_stage(Kl, Vl, proj + 1536 + hh * 64, proj + 3072 + hh * 64,
               [=](int row) { int p = 128 * (j - 1) + row; p = p < 0 ? 0 : p; return (base + (size_t)(p * dil + r)) * INA; }, tid);
    if (tid < 128) *(LAS u32x4*)(Vl + (tid >> 1) * VROWB + 512 + (tid & 1) * 16) = (u32x4){0u, 0u, 0u, 0u};
    const int q0 = wave * 16;
    const size_t row = base + (size_t)((128 * j + q0 + fr) * dil + r);
    bf16* qp = proj + row * INA + hh * 64;
    const bf16x8 qf0 = *(const bf16x8*)(qp + 8 * fq), qf1 = *(const bf16x8*)(qp + 32 + 8 * fq);
    __syncthreads();
    f32x4 o[4]; float lse2;
    attn_core<true>(Kl, Vl, q0, qf0, qf1, j == 0, wave, fr, fq, o, lse2);
    bf16* op = dry ? dryout + (((row * 24 + hh) & 0x7fff) * 64) : qp;
#pragma unroll
    for (int dt = 0; dt < 4; ++dt) { u32x2 w; w.x = pk2(o[dt][0], o[dt][1]); w.y = pk2(o[dt][2], o[dt][3]); *(u32x2*)(op + 16 * dt + 4 * fq) = w; }
    if (fq == 0 && !dry) lse[((size_t)g * MT + row) * 8 + (hh & 7)] = lse2;
    __syncthreads();
}

__global__ void __launch_bounds__(NTHR, 2) fwd_megakernel(Args a) {
    extern __shared__ __attribute__((aligned(16))) unsigned char lds_raw[];
    LAS unsigned char* lds = (LAS unsigned char*)lds_raw;
    cg::grid_group grid = cg::this_grid();
    const int tid = threadIdx.x, lane = tid & 63, wave = __builtin_amdgcn_readfirstlane(tid >> 6), fr = lane & 15, fq = lane >> 4;
    const int G = gridDim.x, cb = blockIdx.x;
    const int gw = cb * NWAVES + wave, NGW = G * NWAVES;
    const size_t gt = (size_t)cb * NTHR + tid, NGT = (size_t)G * NTHR;
    unsigned char* ws = a.ws;
    bf16* WinA = (bf16*)(ws + WS_WINA); bf16* WinB = (bf16*)(ws + WS_WINB); bf16* WoA = (bf16*)(ws + WS_WOA); bf16* WoB = (bf16*)(ws + WS_WOB); bf16* Wkv = (bf16*)(ws + WS_WKV);
    bf16* KV = (bf16*)(ws + WS_KV); float* LSE = (float*)(ws + WS_LSE); float* ROPE = (float*)(ws + WS_ROPE); float* SSQ = (float*)(ws + WS_SSQ);
    bf16* HN = (bf16*)(ws + WS_HN); bf16* Y = HN; bf16* MEMN = (bf16*)(ws + WS_MEMN); bf16* PROJ = (bf16*)(ws + WS_PROJ); bf16* H1B = (bf16*)(ws + WS_H1B);
    const int lo = a.ph_lo, hi = a.ph_hi;
    if (hi < 0) grid.sync();
    volatile LAS unsigned* MISC = (volatile LAS unsigned*)(lds + MISC_OFF);
    if (tid < 32) MISC[tid] = 0u;
    __syncthreads();
    XcdBarrier bar = xcd_barrier_post((unsigned*)(ws + WS_CTL) + CW_BAR, MISC + 8);
#define IN(k) (lo <= (k) && (k) < hi)
#define SEAM(k) do { if (IN(k) && IN((k) + 1)) { xcd_barrier(bar); if (PROBE_SYNC) xcd_barrier(bar); } } while (0)

    if (IN(0)) for (int rep = 0; rep < REPS(0); ++rep) { const bool dry = (PROBE_PH == 0) && rep == 0; (void)dry;
        LAS float* scr = (LAS float*)(lds + wave * 16384);
        constexpr int I_A = 16 * (INA / 32), I_B = 16 * (INB / 32), I_OA = (BRA / 64) * 32, I_OB = (BRB / 64) * 32, I_KV = 16 * (KVW / 32);
        constexpr int NITEMS = I_A + I_B + I_OA + I_OB + 2 * I_KV;
        for (int it = gw; it < NITEMS; it += NGW) {
            int r = it;
            if (r < I_A) { p0_transpose_item(a.attn_w_in, DM, INA, WinA, nullptr, scr, r, lane); continue; } r -= I_A;
            if (r < I_B) { p0_transpose_item(a.conv_w_in, DM, INB, WinB, a.norm_g + DM, scr, r, lane); continue; } r -= I_B;
            if (r < I_OA) { p0_transpose_item(a.attn_w_out, BRA, DM, WoA, nullptr, scr, r, lane); continue; } r -= I_OA;
            if (r < I_OB) { p0_transpose_item(a.conv_w_out, BRB, DM, WoB, nullptr, scr, r, lane); continue; } r -= I_OB;
            if (r < I_KV) { p0_transpose_item(a.w_mem_kv, DM, KVW, Wkv, nullptr, scr, r, lane); continue; } r -= I_KV;
            p0_transpose_item(a.w_mem_kv + (size_t)DM * KVW, DM, KVW, Wkv + (size_t)KVW * DM, nullptr, scr, r, lane);
        }
        for (int m = gw; m < MT; m += NGW) rms_row_to_bf16(a.x + (size_t)m * DM, a.norm_g, HN + (size_t)m * DM, lane);
        for (int m = gw; m < 2 * MEMROWS; m += NGW) { const int L = m / MEMROWS, mr = m % MEMROWS; rms_row_to_bf16(a.mem + (size_t)mr * DM, a.mem_norm_g + L * DM, MEMN + (size_t)m * DM, lane); }
        for (size_t i = gt; i < (size_t)MT * 8; i += NGT) { const int row = (int)(i >> 3), j = (int)(i & 7);
            const float inv = (float)pow(500000.0, -(double)j * 0.125); const float ang = (float)a.pos[row] * inv;
            ROPE[(size_t)row * 16 + j] = (float)cos((double)ang); ROPE[(size_t)row * 16 + 8 + j] = (float)sin((double)ang); }
    }
    SEAM(0);
    if (IN(1)) for (int rep = 0; rep < REPS(1); ++rep) { const bool dry = (PROBE_PH == 1) && rep == 0; (void)dry;
        { pg8::Gemm g{HN, WinA, MT, INA, DM}; pg8::StaticOrder S; S.init(MT, INA, G, cb); pg8::EpiProj0 E{PROJ, INA, ROPE};
          pg8::gemm_phase<pg8::EpiProj0, pg8::StaticOrder, true, true>(lds, g, S, E); }
        const int c1 = cb - G / 2;
        if (c1 >= 0 && c1 < 16) { pg8::Gemm g{MEMN, Wkv, MEMROWS, KVW, DM}; pg8::StaticOrder S; S.init(MEMROWS, KVW, G, c1); pg8::EpiPlain E{KV, KVW};
          pg8::gemm_phase<pg8::EpiPlain, pg8::StaticOrder, true, true>(lds, g, S, E); }
        if (c1 >= 16 && c1 < 32) { pg8::Gemm g{MEMN + (size_t)MEMROWS * DM, Wkv + (size_t)KVW * DM, MEMROWS, KVW, DM}; pg8::StaticOrder S; S.init(MEMROWS, KVW, G, c1 - 16); pg8::EpiPlain E{KV + (size_t)MEMROWS * KVW, KVW};
          pg8::gemm_phase<pg8::EpiPlain, pg8::StaticOrder, true, true>(lds, g, S, E); }
    }
    SEAM(1);
    if (IN(2)) for (int rep = 0; rep < REPS(2); ++rep) { const bool dry = (PROBE_PH == 2) && rep == 0; (void)dry;
        for (int u = cb; u < 512; u += G) mem_attn_unit(u, PROJ, INA, 4608, 4864 + 512, KV, Y, BRA, 512, lds, tid, wave, fr, fq);
        for (int u = cb; u < 3072; u += G) dil_attn_unit(u, PROJ, LSE, lds, tid, wave, fr, fq, dry, (bf16*)(ws + WS_END));
    }
    SEAM(2);
    if (IN(3)) for (int rep = 0; rep < REPS(3); ++rep) { const bool dry = (PROBE_PH == 3) && rep == 0; (void)dry;
        for (size_t it = gt; it < (size_t)MT * 64; it += NGT) { const size_t row = it >> 6; const int c = (int)(it & 63), h = c >> 3;
            const float l0 = LSE[row * 8 + h], l1 = LSE[((size_t)MT + row) * 8 + h], l2 = LSE[((size_t)2 * MT + row) * 8 + h];
            const float mx = fmaxf(l0, fmaxf(l1, l2)); float w0 = __builtin_amdgcn_exp2f(l0 - mx), w1 = __builtin_amdgcn_exp2f(l1 - mx), w2 = __builtin_amdgcn_exp2f(l2 - mx);
            const float inv = 1.0f / (w0 + w1 + w2); w0 *= inv; w1 *= inv; w2 *= inv;
            const bf16* pr = PROJ + row * INA + c * 8;
            const u32x4 o0 = *(const u32x4*)pr, o1 = *(const u32x4*)(pr + 512), o2 = *(const u32x4*)(pr + 1024), z = *(const u32x4*)(pr + 4864);
            u32x4 y;
#pragma unroll
            for (int k = 0; k < 4; ++k) { const float mlo = w0 * bflo(o0[k]) + w1 * bflo(o1[k]) + w2 * bflo(o2[k]), mhi = w0 * bfhi(o0[k]) + w1 * bfhi(o1[k]) + w2 * bfhi(o2[k]);
                y[k] = pk2(mlo * silu(bflo(z[k])), mhi * silu(bfhi(z[k]))); }
            *(u32x4*)(Y + row * BRA + c * 8) = y; }
    }
    SEAM(3);
    if (IN(4)) for (int rep = 0; rep < REPS(4); ++rep) { const bool dry = (PROBE_PH == 4) && rep == 0; (void)dry;
        pg8::Gemm g{Y, WoA, MT, DM, BRA}; pg8::StaticOrder S; S.init(MT, DM, G, cb); pg8::EpiH1 E{a.x, a.out, H1B, SSQ};
        pg8::gemm_phase<pg8::EpiH1, pg8::StaticOrder, true, true>(lds, g, S, E);
    }
    SEAM(4);
    if (IN(5)) for (int rep = 0; rep < REPS(5); ++rep) { const bool dry = (PROBE_PH == 5) && rep == 0; (void)dry;
        pg8::Gemm g{H1B, WinB, MT, INB, DM}; pg8::StaticOrder S; S.init(MT, INB, G, cb); pg8::EpiProj1 E{PROJ, INB, SSQ};
        pg8::gemm_phase<pg8::EpiProj1, pg8::StaticOrder, true, true>(lds, g, S, E);
    }
    SEAM(5);
    if (IN(6)) for (int rep = 0; rep < REPS(6); ++rep) { const bool dry = (PROBE_PH == 6) && rep == 0; (void)dry;
        for (int u = cb; u < 512; u += G) mem_attn_unit(u, PROJ, INB, 3072, 3328 + 1024, KV + (size_t)MEMROWS * KVW, Y, BRB, 1024, lds, tid, wave, fr, fq);
        for (size_t it = gt; it < (size_t)(MT / 16) * 128; it += NGT) { const size_t t0 = (it >> 7) * 16; const int c = (int)(it & 127);
            const f32x4* cw = (const f32x4*)(a.conv_w + c * 8);
            const f32x4 w0a = cw[0], w0b = cw[1], w1a = cw[256], w1b = cw[257], w2a = cw[512], w2b = cw[513];
            float w0[8] = {w0a[0], w0a[1], w0a[2], w0a[3], w0b[0], w0b[1], w0b[2], w0b[3]}, w1[8] = {w1a[0], w1a[1], w1a[2], w1a[3], w1b[0], w1b[1], w1b[2], w1b[3]},
                  w2[8] = {w2a[0], w2a[1], w2a[2], w2a[3], w2b[0], w2b[1], w2b[2], w2b[3]};
            float am2[8], am1[8];
            if ((t0 & (SEQ - 1)) == 0) {
#pragma unroll
                for (int k = 0; k < 8; ++k) { am2[k] = 0.f; am1[k] = 0.f; }
            } else { const bf16* p2 = PROJ + (t0 - 2) * INB + c * 8; const bf16* p1 = PROJ + (t0 - 1) * INB + c * 8;
                const u32x4 c2 = *(const u32x4*)(p2 + 1024), u2 = *(const u32x4*)(p2 + 2048), c1 = *(const u32x4*)(p1 + 1024), u1 = *(const u32x4*)(p1 + 2048);
#pragma unroll
                for (int k = 0; k < 4; ++k) { am2[2 * k] = bflo(c2[k]) * bflo(u2[k]); am2[2 * k + 1] = bfhi(c2[k]) * bfhi(u2[k]); am1[2 * k] = bflo(c1[k]) * bflo(u1[k]); am1[2 * k + 1] = bfhi(c1[k]) * bfhi(u1[k]); } }
#pragma unroll 4
            for (int tt = 0; tt < 16; ++tt) { const bf16* p = PROJ + (t0 + tt) * INB + c * 8;
                const u32x4 bg = *(const u32x4*)p, cg_ = *(const u32x4*)(p + 1024), uu = *(const u32x4*)(p + 2048), zz = *(const u32x4*)(p + 3328);
                float a0[8], yv[8];
#pragma unroll
                for (int k = 0; k < 4; ++k) { a0[2 * k] = bflo(cg_[k]) * bflo(uu[k]); a0[2 * k + 1] = bfhi(cg_[k]) * bfhi(uu[k]); }
#pragma unroll
                for (int k = 0; k < 8; ++k) { const float cv = w0[k] * am2[k] + w1[k] * am1[k] + w2[k] * a0[k]; const unsigned bw = bg[k >> 1], zw = zz[k >> 1];
                    const float bgv = (k & 1) ? bfhi(bw) : bflo(bw), zv = (k & 1) ? bfhi(zw) : bflo(zw); yv[k] = bgv * cv * silu(zv); am2[k] = am1[k]; am1[k] = a0[k]; }
                u32x4 y; y.x = pk2(yv[0], yv[1]); y.y = pk2(yv[2], yv[3]); y.z = pk2(yv[4], yv[5]); y.w = pk2(yv[6], yv[7]);
                *(u32x4*)(Y + (t0 + tt) * BRB + c * 8) = y; } }
    }
    SEAM(6);
    if (IN(7)) for (int rep = 0; rep < REPS(7); ++rep) { const bool dry = (PROBE_PH == 7) && rep == 0; (void)dry;
        pg8::Gemm g{Y, WoB, MT, DM, BRB}; pg8::StaticOrder S; S.init(MT, DM, G, cb); pg8::EpiH2 E{a.out, dry ? (float*)PROJ : a.out};
        pg8::gemm_phase<pg8::EpiH2, pg8::StaticOrder, true, true>(lds, g, S, E);
    }
    SEAM(7);
    if (IN(8)) for (int rep = 0; rep < REPS(8); ++rep) { const bool dry = (PROBE_PH == 8) && rep == 0; (void)dry;
        for (int m = gw; m < MT; m += NGW) { f32x4* xr = (f32x4*)(a.out + (size_t)m * DM) + lane; const f32x4* gr = (const f32x4*)a.final_g + lane; f32x4* xo = dry ? (f32x4*)((float*)PROJ + (size_t)m * DM) + lane : xr;
            f32x4 v[4]; float s = 0.f;
#pragma unroll
            for (int j = 0; j < 4; ++j) { v[j] = xr[64 * j]; s += (v[j].x * v[j].x + v[j].y * v[j].y) + (v[j].z * v[j].z + v[j].w * v[j].w); }
            const float r = 1.0f / sqrtf(wave_sum(s) * (1.f / DM) + RMS_EPS);
#pragma unroll
            for (int j = 0; j < 4; ++j) xo[64 * j] = v[j] * r * gr[64 * j]; }
    }
#undef IN
#undef SEAM
}

constexpr int N_PHASES = 9;
extern "C" void kernel_launch(void* const* d_in, const int* in_sizes, int n_in, void* d_out, int out_size, void* d_ws, size_t ws_size, hipStream_t stream) {
    static int grid = 0;
    if (grid == 0) {
        int dev = 0, cus = 0, per_cu = 0;
        hipGetDevice(&dev); hipDeviceGetAttribute(&cus, hipDeviceAttributeMultiprocessorCount, dev);
        if (hipFuncSetAttribute((const void*)fwd_megakernel, hipFuncAttributeMaxDynamicSharedMemorySize, LDS_BYTES) != hipSuccess) fprintf(stderr, "kernel_launch: hipFuncSetAttribute failed\n");
        if (hipOccupancyMaxActiveBlocksPerMultiprocessor(&per_cu, (const void*)fwd_megakernel, NTHR, LDS_BYTES) != hipSuccess || per_cu < 1) { fprintf(stderr, "kernel_launch: occupancy query gave %d\n", per_cu); per_cu = 1; }
        (void)hipGetLastError();
        grid = cus * 1;
        if (ws_size < WS_END) { fprintf(stderr, "kernel_launch: workspace too small (%zu)\n", ws_size); grid = -1; }
    }
    if (grid < 0) return;
    if (hipMemsetAsync((char*)d_ws + WS_CTL, 0, CTL_ZERO_BYTES, stream) != hipSuccess) { fprintf(stderr, "kernel_launch: memset failed\n"); return; }
    Args a{};
    a.x = (const float*)d_in[0]; a.mem = (const float*)d_in[1]; a.pos = (const int*)d_in[2]; a.norm_g = (const float*)d_in[3]; a.mem_norm_g = (const float*)d_in[4];
    a.w_mem_kv = (const float*)d_in[5]; a.attn_w_in = (const float*)d_in[6]; a.attn_w_out = (const float*)d_in[7]; a.conv_w_in = (const float*)d_in[8];
    a.conv_w = (const float*)d_in[9]; a.conv_w_out = (const float*)d_in[10]; a.final_g = (const float*)d_in[11]; a.out = (float*)d_out; a.ws = (unsigned char*)d_ws;
#if MK_PER_PHASE
    for (int p = 0; p < N_PHASES; ++p) { a.ph_lo = p; a.ph_hi = p + 1; hipLaunchKernelGGL(fwd_megakernel, dim3(grid), dim3(NTHR), LDS_BYTES, stream, a); }
#else
    a.ph_lo = 0; a.ph_hi = N_PHASES;
    void* args[] = {&a};
    hipError_t e = hipLaunchCooperativeKernel((const void*)fwd_megakernel, dim3(grid), dim3(NTHR), args, LDS_BYTES, stream);
    if (e != hipSuccess) fprintf(stderr, "kernel_launch: cooperative launch failed: %s (grid %d)\n", hipGetErrorString(e), grid);
#endif
}
```

```cpp
#include <hip/hip_runtime.h>
#include <hip/hip_cooperative_groups.h>
#include <cstdio>
#include <cstdint>
namespace cg = cooperative_groups;
#ifndef MK_PER_PHASE
#define MK_PER_PHASE 0
#endif
#define PROBE_PH (-1)
#define PROBE_SYNC 0
#define REPS(k) ((k) == PROBE_PH ? 2 : 1)
namespace pg8 {
#define PG8_LAS __attribute__((address_space(3)))
typedef unsigned short bf16_t;
typedef short bf16x8 __attribute__((ext_vector_type(8)));
typedef float f32x4 __attribute__((ext_vector_type(4)));
typedef unsigned u32x4 __attribute__((ext_vector_type(4)));
constexpr int BM = 256, BK = 64, HALF = 128, HTB = HALF * BK * 2  , STAGE_BYTES = 8 * HTB, NXCD = 8, WGM = 8;

__host__ __device__ __forceinline__ int lds_byte(int r, int c) { const int st = (r >> 4) * 2 + (c >> 5), rr = r & 15, cc = c & 31, ob = rr * 64 + cc * 2; return st * 1024 + (ob ^ (((ob >> 9) & 1) << 5)); }
__host__ __device__ __forceinline__ void stage_rc(int b, int& R, int& C) { const int st = b / 1024, sb = b % 1024, swz = sb ^ (((sb >> 9) & 1) << 5); R = (st >> 1) * 16 + swz / 64; C = (st & 1) * 32 + (swz % 64) / 2; }
__host__ __device__ __forceinline__ int perm32(int rho) { const int n = rho >> 4, i = rho & 15; return 8 * (i >> 2) + 4 * n + (i & 3); }

struct Unit { int pm, pn; };
struct Gemm { const bf16_t* A; const bf16_t* Bt; int M, N, K; };

struct StaticOrder {
    int nM, nN, nwg, G, c;
    __host__ __device__ void init(int M, int N, int G_, int c_) { nM = M / BM; nN = N / BM; nwg = nM * nN; G = G_; c = c_; }
    __host__ __device__ bool next(int i, Unit& u) const {
        const long L = (long)i * G + c; if (L >= nwg) return false;
        int wgid = (int)L; { const int q = nwg / NXCD, r = nwg % NXCD, xcd = wgid % NXCD, off = wgid / NXCD; wgid = (xcd < r ? xcd * (q + 1) : r * (q + 1) + (xcd - r) * q) + off; }
        const int nig = WGM * nN, gid = wgid / nig, fm = gid * WGM, gsz = (nM - fm) < WGM ? (nM - fm) : WGM;
        u.pm = fm + ((wgid % nig) % gsz); u.pn = (wgid % nig) / gsz; return true;
    }
    __device__ __forceinline__ void a_ready(const Unit&) const {}
    __device__ __forceinline__ void done(const Unit&) const {}
};
__device__ __forceinline__ unsigned cvt_pk_bf16(float lo, float hi) { unsigned r; asm volatile("v_cvt_pk_bf16_f32 %0, %1, %2" : "=v"(r) : "v"(lo), "v"(hi)); return r; }
typedef float f32x2 __attribute__((ext_vector_type(2)));
constexpr float QK_C2 = 0.125f * 1.4426950408889634f;
struct EpiPlain {
    static constexpr bool PERM = true, AFTER_DRAIN = false;
    bf16_t* O; int ldc;
    __device__ __forceinline__ void operator()(f32x4 (&acc)[2][2][4][2], const Unit& u, int wr, int wc, int fr, int fq) const {
        const int row0 = u.pm * BM + wr * 64 + fr, col0 = u.pn * BM + wc * 32 + 8 * fq;
#pragma unroll
        for (int ai = 0; ai < 2; ++ai)
#pragma unroll
            for (int m = 0; m < 4; ++m) { bf16_t* rowp = O + (size_t)(row0 + ai * HALF + m * 16) * ldc + col0;
#pragma unroll
                for (int bj = 0; bj < 2; ++bj) { const f32x4 v0 = acc[ai][bj][m][0], v1 = acc[ai][bj][m][1];
                    u32x4 w; w.x = cvt_pk_bf16(v0[0], v0[1]); w.y = cvt_pk_bf16(v0[2], v0[3]); w.z = cvt_pk_bf16(v1[0], v1[1]); w.w = cvt_pk_bf16(v1[2], v1[3]);
                    *(u32x4*)(rowp + bj * HALF) = w; } }
    }
};
struct EpiProj0 {
    static constexpr bool PERM = true, AFTER_DRAIN = false;
    bf16_t* O; int ldc; const float* rope;
    __device__ __forceinline__ void operator()(f32x4 (&acc)[2][2][4][2], const Unit& u, int wr, int wc, int fr, int fq) const {
        const int pn = u.pn, row0 = u.pm * BM + wr * 64 + fr, col0 = pn * BM + wc * 32 + 8 * fq;
        if (pn < 12 && (wc & 1) == 0) {
            const float sgn = fq == 0 ? -1.f : 1.f; const bool act = fq < 2;
#pragma unroll
            for (int ai = 0; ai < 2; ++ai)
#pragma unroll
                for (int m = 0; m < 4; ++m) { const f32x4* rp = (const f32x4*)(rope + (size_t)(row0 + ai * HALF + m * 16) * 16);
                    const f32x4 c0 = rp[0], c1 = rp[1], s0 = rp[2], s1 = rp[3];
#pragma unroll
                    for (int bj = 0; bj < 2; ++bj) { const f32x4 v0 = acc[ai][bj][m][0], v1 = acc[ai][bj][m][1]; f32x4 p0, p1;
#pragma unroll
                        for (int k = 0; k < 4; ++k) { p0[k] = __shfl_xor(v0[k], 16); p1[k] = __shfl_xor(v1[k], 16); }
                        if (act) { acc[ai][bj][m][0] = v0 * c0 + (p0 * s0) * sgn; acc[ai][bj][m][1] = v1 * c1 + (p1 * s1) * sgn; } } }
        }
        const float sc = (pn < 6 || pn == 18) ? QK_C2 : 1.f;
#pragma unroll
        for (int ai = 0; ai < 2; ++ai)
#pragma unroll
            for (int m = 0; m < 4; ++m) { bf16_t* rowp = O + (size_t)(row0 + ai * HALF + m * 16) * ldc + col0;
#pragma unroll
                for (int bj = 0; bj < 2; ++bj) { const f32x4 v0 = acc[ai][bj][m][0] * sc, v1 = acc[ai][bj][m][1] * sc;
                    u32x4 w; w.x = cvt_pk_bf16(v0[0], v0[1]); w.y = cvt_pk_bf16(v0[2], v0[3]); w.z = cvt_pk_bf16(v1[0], v1[1]); w.w = cvt_pk_bf16(v1[2], v1[3]);
                    *(u32x4*)(rowp + bj * HALF) = w; } }
    }
};
struct EpiH1 {
    static constexpr bool PERM = true, AFTER_DRAIN = false;
    const float* x; float* h1; bf16_t* h1b; float* ssq;
    __device__ __forceinline__ void operator()(f32x4 (&acc)[2][2][4][2], const Unit& u, int wr, int wc, int fr, int fq) const {
        const int row0 = u.pm * BM + wr * 64 + fr, col0 = u.pn * BM + wc * 32 + 8 * fq;
#pragma unroll
        for (int ai = 0; ai < 2; ++ai)
#pragma unroll
            for (int m = 0; m < 4; ++m) { const int row = row0 + ai * HALF + m * 16; const size_t off = (size_t)row * 1024 + col0; float ss = 0.f;
#pragma unroll
                for (int bj = 0; bj < 2; ++bj) { const f32x4 x0 = *(const f32x4*)(x + off + bj * HALF), x1 = *(const f32x4*)(x + off + bj * HALF + 4);
                    const f32x4 v0 = acc[ai][bj][m][0] + x0, v1 = acc[ai][bj][m][1] + x1;
                    *(f32x4*)(h1 + off + bj * HALF) = v0; *(f32x4*)(h1 + off + bj * HALF + 4) = v1;
                    u32x4 w; w.x = cvt_pk_bf16(v0[0], v0[1]); w.y = cvt_pk_bf16(v0[2], v0[3]); w.z = cvt_pk_bf16(v1[0], v1[1]); w.w = cvt_pk_bf16(v1[2], v1[3]);
                    *(u32x4*)(h1b + off + bj * HALF) = w;
                    ss += (v0[0] * v0[0] + v0[1] * v0[1]) + (v0[2] * v0[2] + v0[3] * v0[3]) + (v1[0] * v1[0] + v1[1] * v1[1]) + (v1[2] * v1[2] + v1[3] * v1[3]); }
                ss += __shfl_xor(ss, 16); ss += __shfl_xor(ss, 32);
                if (fq == 0) ssq[(size_t)row * 16 + u.pn * 4 + wc] = ss; }
    }
};
struct EpiProj1 {
    static constexpr bool PERM = true, AFTER_DRAIN = false;
    bf16_t* O; int ldc; const float* ssq;
    __device__ __forceinline__ void operator()(f32x4 (&acc)[2][2][4][2], const Unit& u, int wr, int wc, int fr, int fq) const {
        const int row0 = u.pm * BM + wr * 64 + fr, col0 = u.pn * BM + wc * 32 + 8 * fq; const float sc = (u.pn == 12) ? QK_C2 : 1.f;
#pragma unroll
        for (int ai = 0; ai < 2; ++ai)
#pragma unroll
            for (int m = 0; m < 4; ++m) { const int row = row0 + ai * HALF + m * 16; const f32x4* sp = (const f32x4*)(ssq + (size_t)row * 16);
                const f32x4 a = sp[0], b = sp[1], c = sp[2], d = sp[3];
                const float tot = ((a[0] + a[1]) + (a[2] + a[3])) + ((b[0] + b[1]) + (b[2] + b[3])) + ((c[0] + c[1]) + (c[2] + c[3])) + ((d[0] + d[1]) + (d[2] + d[3]));
                const float r = sc / sqrtf(tot * (1.0f / 1024.0f) + 1e-6f);
                bf16_t* rowp = O + (size_t)row * ldc + col0;
#pragma unroll
                for (int bj = 0; bj < 2; ++bj) { const f32x4 v0 = acc[ai][bj][m][0] * r, v1 = acc[ai][bj][m][1] * r;
                    u32x4 w; w.x = cvt_pk_bf16(v0[0], v0[1]); w.y = cvt_pk_bf16(v0[2], v0[3]); w.z = cvt_pk_bf16(v1[0], v1[1]); w.w = cvt_pk_bf16(v1[2], v1[3]);
                    *(u32x4*)(rowp + bj * HALF) = w; } }
    }
};
struct EpiH2 {
    static constexpr bool PERM = true, AFTER_DRAIN = false;
    const float* h; float* ho;
    __device__ __forceinline__ void operator()(f32x4 (&acc)[2][2][4][2], const Unit& u, int wr, int wc, int fr, int fq) const {
        const int row0 = u.pm * BM + wr * 64 + fr, col0 = u.pn * BM + wc * 32 + 8 * fq;
#pragma unroll
        for (int ai = 0; ai < 2; ++ai)
#pragma unroll
            for (int m = 0; m < 4; ++m) { const size_t off = (size_t)(row0 + ai * HALF + m * 16) * 1024 + col0;
#pragma unroll
                for (int bj = 0; bj < 2; ++bj) { const f32x4 x0 = *(const f32x4*)(h + off + bj * HALF), x1 = *(const f32x4*)(h + off + bj * HALF + 4);
                    *(f32x4*)(ho + off + bj * HALF) = acc[ai][bj][m][0] + x0; *(f32x4*)(ho + off + bj * HALF + 4) = acc[ai][bj][m][1] + x1; } }
    }
};

template <class Epi, class Sched, bool ALIGN_EPI = false, bool SP2 = false>
__device__ __forceinline__ void gemm_phase(PG8_LAS unsigned char* lds, const Gemm g, const Sched& S, const Epi& E) {
    const int tid = threadIdx.x, wid = __builtin_amdgcn_readfirstlane(tid >> 6), lane = tid & 63, wr = wid >> 2, wc = wid & 3, fr = lane & 15, fq = lane >> 4;
    const int K = g.K, nt = K / BK;
    unsigned voffA[2], voffB[2];
#pragma unroll
    for (int i = 0; i < 2; ++i) { int R, C; stage_rc(tid * 16 + i * 8192, R, C); const int Rb = Epi::PERM ? ((R & ~31) + perm32(R & 31)) : R;
        voffA[i] = (unsigned)(R * K + C) * 2u; voffB[i] = (unsigned)(Rb * K + C) * 2u; }
    const size_t kstep = (size_t)(BK * 2);
    const size_t hstep = (size_t)HALF * K * 2;
    const size_t tstep = 2 * hstep;
    const unsigned ldsw = (unsigned)wid * 1024u;
    const int aoff = lds_byte(wr * 64 + fr, fq * 8), boff = lds_byte(wc * 32 + fr, fq * 8);
#define PG8_SA(b, h) (((b) * 2 + (h)) * HTB)
#define PG8_SB(b, h) ((4 + (b) * 2 + (h)) * HTB)
#define PG8_STAGE(bufoff, gbase, voff) do { _Pragma("unroll") for (int _i = 0; _i < 2; ++_i) \
        __builtin_amdgcn_global_load_lds((const unsigned*)((const char*)(gbase) + (voff)[_i]), (PG8_LAS unsigned*)(lds + (bufoff) + ldsw + _i * 8192), 16, 0, 0); } while (0)
#define PG8_LDA(dst, b, h) do { _Pragma("unroll") for (int m = 0; m < 4; ++m) _Pragma("unroll") for (int k = 0; k < 2; ++k) dst[m][k] = *(const PG8_LAS bf16x8*)(lds + PG8_SA(b, h) + aoff + m * 2048 + k * 1024); } while (0)
#define PG8_LDB(dst, b, h) do { _Pragma("unroll") for (int n = 0; n < 2; ++n) _Pragma("unroll") for (int k = 0; k < 2; ++k) dst[n][k] = *(const PG8_LAS bf16x8*)(lds + PG8_SB(b, h) + boff + n * 2048 + k * 1024); } while (0)
#define PG8_MMA(ai, bj, At, Bt) do { __builtin_amdgcn_s_setprio(1); _Pragma("unroll") for (int m = 0; m < 4; ++m) _Pragma("unroll") for (int n = 0; n < 2; ++n) _Pragma("unroll") for (int k = 0; k < 2; ++k) \
        acc[ai][bj][m][n] = __builtin_amdgcn_mfma_f32_16x16x32_bf16(Bt[n][k], At[m][k], acc[ai][bj][m][n], 0, 0, 0); __builtin_amdgcn_s_setprio(0); } while (0)
#define PG8_WAIT_V(n) asm volatile("s_waitcnt vmcnt(" #n ")" ::: "memory")
#define PG8_WAIT_L(n) asm volatile("s_waitcnt lgkmcnt(" #n ")" ::: "memory")
#define PG8_BAR __builtin_amdgcn_s_barrier()
#define PG8_SCHED __builtin_amdgcn_sched_barrier(0)
    Unit cur, nxt; int ui = 0;
    if (!S.next(0, cur)) return;
    f32x4 acc[2][2][4][2];
#pragma unroll
    for (int a = 0; a < 2; ++a)
#pragma unroll
        for (int b = 0; b < 2; ++b)
#pragma unroll
            for (int m = 0; m < 4; ++m)
#pragma unroll
                for (int n = 0; n < 2; ++n) acc[a][b][m][n] = (f32x4){0.f, 0.f, 0.f, 0.f};
    bf16x8 At[4][2], B0[2][2], B1[2][2];
    const char* cA = (const char*)g.A + (size_t)cur.pm * tstep; const char* cB = (const char*)g.Bt + (size_t)cur.pn * tstep;
    S.a_ready(cur);
    if constexpr (SP2) {
        PG8_STAGE(PG8_SB(0, 0), cB, voffB); PG8_STAGE(PG8_SB(0, 1), cB + hstep, voffB); PG8_STAGE(PG8_SA(0, 0), cA, voffA); PG8_STAGE(PG8_SA(0, 1), cA + hstep, voffA);
        if (wr == 1) PG8_BAR;
        PG8_WAIT_V(2); PG8_BAR;
        PG8_STAGE(PG8_SB(1, 0), cB + kstep, voffB); PG8_STAGE(PG8_SA(1, 0), cA + kstep, voffA); PG8_STAGE(PG8_SB(1, 1), cB + hstep + kstep, voffB);
        PG8_WAIT_V(6); PG8_BAR;
    } else {
        PG8_STAGE(PG8_SB(0, 0), cB, voffB); PG8_STAGE(PG8_SA(0, 0), cA, voffA); PG8_STAGE(PG8_SB(0, 1), cB + hstep, voffB); PG8_STAGE(PG8_SA(0, 1), cA + hstep, voffA);
        if (wr == 1) PG8_BAR;
        PG8_WAIT_V(4); PG8_BAR;
        PG8_STAGE(PG8_SB(1, 0), cB + kstep, voffB); PG8_STAGE(PG8_SA(1, 0), cA + kstep, voffA); PG8_STAGE(PG8_SB(1, 1), cB + hstep + kstep, voffB);
        PG8_WAIT_V(6); PG8_BAR;
    }
    for (;;) {
        const bool has_next = S.next(ui + 1, nxt);
        const char* nA = has_next ? (const char*)g.A + (size_t)nxt.pm * tstep : cA; const char* nB = has_next ? (const char*)g.Bt + (size_t)nxt.pn * tstep : cB;
        for (int t = 0; t < nt; t += 2) {
            const bool last = (t == nt - 2);
            const char* a1 = cA + (size_t)(t + 1) * kstep;
            const char* a2 = last ? nA : cA + (size_t)(t + 2) * kstep; const char* b2 = last ? nB : cB + (size_t)(t + 2) * kstep;
            const char* a3 = a2 + kstep; const char* b3 = b2 + kstep;
            if (last && has_next) S.a_ready(nxt);
            if constexpr (SP2) {
            PG8_LDB(B0, 0, 0); PG8_LDB(B1, 0, 1); PG8_SCHED; PG8_LDA(At, 0, 0); PG8_STAGE(PG8_SA(1, 1), a1 + hstep, voffA);
            PG8_WAIT_V(8); PG8_WAIT_L(0); PG8_BAR; PG8_MMA(0, 0, At, B0); PG8_MMA(0, 1, At, B1); PG8_BAR; PG8_SCHED;
            PG8_LDA(At, 0, 1); PG8_STAGE(PG8_SB(0, 0), b2, voffB); PG8_STAGE(PG8_SB(0, 1), b2 + hstep, voffB); PG8_STAGE(PG8_SA(0, 0), a2, voffA);
            PG8_WAIT_V(8); PG8_WAIT_L(0); PG8_BAR; PG8_MMA(1, 0, At, B0); PG8_MMA(1, 1, At, B1); PG8_BAR; PG8_SCHED;
            PG8_LDB(B0, 1, 0); PG8_LDB(B1, 1, 1); PG8_SCHED; PG8_LDA(At, 1, 0); PG8_STAGE(PG8_SA(0, 1), a2 + hstep, voffA);
            PG8_WAIT_V(8); PG8_WAIT_L(0); PG8_BAR; PG8_MMA(0, 0, At, B0); PG8_MMA(0, 1, At, B1); PG8_BAR; PG8_SCHED;
            PG8_LDA(At, 1, 1); PG8_STAGE(PG8_SB(1, 0), b3, voffB); PG8_STAGE(PG8_SB(1, 1), b3 + hstep, voffB); PG8_STAGE(PG8_SA(1, 0), a3, voffA);
            PG8_WAIT_V(8); PG8_WAIT_L(0); PG8_BAR; PG8_MMA(1, 0, At, B0); PG8_MMA(1, 1, At, B1); PG8_BAR; PG8_SCHED;
            } else {
            PG8_LDB(B0, 0, 0); PG8_SCHED; PG8_LDA(At, 0, 0); PG8_STAGE(PG8_SA(1, 1), a1 + hstep, voffA);
            PG8_WAIT_L(8); PG8_BAR; PG8_WAIT_L(0); PG8_MMA(0, 0, At, B0); PG8_BAR; PG8_SCHED;
            PG8_LDB(B1, 0, 1); PG8_STAGE(PG8_SB(0, 0), b2, voffB);
            PG8_BAR; PG8_WAIT_L(0); PG8_MMA(0, 1, At, B1); PG8_BAR;
            PG8_LDA(At, 0, 1); PG8_STAGE(PG8_SA(0, 0), a2, voffA);
            PG8_BAR; PG8_WAIT_L(0); PG8_MMA(1, 0, At, B0); PG8_BAR; PG8_SCHED;
            PG8_STAGE(PG8_SB(0, 1), b2 + hstep, voffB);
            PG8_WAIT_V(6); PG8_BAR; PG8_MMA(1, 1, At, B1); PG8_BAR;
            PG8_LDB(B0, 1, 0); PG8_SCHED; PG8_LDA(At, 1, 0); PG8_STAGE(PG8_SA(0, 1), a2 + hstep, voffA);
            PG8_WAIT_L(8); PG8_BAR; PG8_WAIT_L(0); PG8_MMA(0, 0, At, B0); PG8_BAR; PG8_SCHED;
            PG8_LDB(B1, 1, 1); PG8_STAGE(PG8_SB(1, 0), b3, voffB);
            PG8_BAR; PG8_WAIT_L(0); PG8_MMA(0, 1, At, B1); PG8_BAR;
            PG8_LDA(At, 1, 1); PG8_STAGE(PG8_SA(1, 0), a3, voffA);
            PG8_BAR; PG8_WAIT_L(0); PG8_MMA(1, 0, At, B0); PG8_BAR; PG8_SCHED;
            PG8_STAGE(PG8_SB(1, 1), b3 + hstep, voffB);
            PG8_WAIT_V(6); PG8_BAR; PG8_MMA(1, 1, At, B1); PG8_BAR;
            }
        }
        if constexpr (ALIGN_EPI) { if (wr == 0) PG8_BAR; }
        if constexpr (!Epi::AFTER_DRAIN) { E(acc, cur, wr, wc, fr, fq); S.done(cur); }
        if (!has_next) break;
#pragma unroll
        for (int a = 0; a < 2; ++a)
#pragma unroll
            for (int b = 0; b < 2; ++b)
#pragma unroll
                for (int m = 0; m < 4; ++m)
#pragma unroll
                    for (int n = 0; n < 2; ++n) acc[a][b][m][n] = (f32x4){0.f, 0.f, 0.f, 0.f};
        cur = nxt; cA = nA; cB = nB; ++ui;
        if constexpr (ALIGN_EPI) { if (wr == 1) PG8_BAR; }
    }
    PG8_WAIT_V(0);
    if constexpr (!ALIGN_EPI) { if (wr == 0) PG8_BAR; }
    PG8_BAR;
    if constexpr (Epi::AFTER_DRAIN) { E.fused(acc, cur, wr, wc, fr, fq, lds, wid, lane); S.done(cur); }
#undef PG8_SA
#undef PG8_SB
#undef PG8_STAGE
#undef PG8_LDA
#undef PG8_LDB
#undef PG8_MMA
#undef PG8_WAIT_V
#undef PG8_WAIT_L
#undef PG8_BAR
#undef PG8_SCHED
}
}
constexpr int NB = 8, SEQ = 2048, DM = 1024, MT = NB * SEQ;
constexpr int INA = 5632, INB = 4608, BRA = 768, BRB = 1280, NMEM = 256, MEMROWS = NB * NMEM, KVW = 512;
constexpr float RMS_EPS = 1e-6f;
constexpr size_t MiB = 1u << 20;
constexpr size_t WS_WINA = 1 * MiB, WS_WINB = 12 * MiB, WS_WOA = 21 * MiB, WS_WOB = 23 * MiB, WS_WKV = 26 * MiB;
constexpr size_t WS_KV = 28 * MiB;
constexpr size_t WS_LSE = 32 * MiB;
constexpr size_t WS_ROPE = 34 * MiB;
constexpr size_t WS_SSQ = 35 * MiB;
constexpr size_t WS_HN = 36 * MiB;
constexpr size_t WS_MEMN = 68 * MiB;
constexpr size_t WS_PROJ = 76 * MiB;
constexpr size_t WS_H1B = 220 * MiB;
constexpr size_t WS_END = 252 * MiB;
static_assert(WS_PROJ + (size_t)MT * INA * 2 <= WS_END && WS_PROJ + (size_t)MT * INB * 2 <= WS_H1B && WS_HN + (size_t)MT * BRB * 2 <= WS_PROJ, "d_ws map");

#define LAS __attribute__((address_space(3)))
typedef unsigned short bf16;
typedef unsigned u32x4 __attribute__((ext_vector_type(4)));
typedef unsigned u32x2 __attribute__((ext_vector_type(2)));
typedef float f32x4 __attribute__((ext_vector_type(4)));
typedef short bf16x8 __attribute__((ext_vector_type(8)));
constexpr int NTHR = 512, NWAVES = 8;
constexpr int LDS_BYTES = 147456;
constexpr int MISC_OFF = 131072 + 320;
constexpr size_t WS_CTL = 0, CTL_ZERO_BYTES = 65536;
constexpr int CW_BAR = 1024;

__device__ __forceinline__ unsigned f2bf(float f) { unsigned u = __builtin_bit_cast(unsigned, f); return (u + 0x7fffu + ((u >> 16) & 1u)) >> 16; }
__device__ __forceinline__ unsigned pk2(float lo, float hi) { return f2bf(lo) | (f2bf(hi) << 16); }
__device__ __forceinline__ float bflo(unsigned w) { return __builtin_bit_cast(float, w << 16); }
__device__ __forceinline__ float bfhi(unsigned w) { return __builtin_bit_cast(float, w & 0xffff0000u); }
__device__ __forceinline__ float wave_sum(float v) {
#pragma unroll
    for (int o = 1; o < 64; o <<= 1) v += __shfl_xor(v, o);
    return v;
}
__device__ __forceinline__ float silu(float z) { return z / (1.0f + __expf(-z)); }

__device__ __forceinline__ void p0_transpose_item(const float* W, int K, int N, bf16* WT, const float* g, LAS float* scr, int item, int lane) {
    const int nblk = N / 32, kb = item / nblk, nb = item % nblk, k0 = 64 * kb, n0 = 32 * nb;
#pragma unroll 8
    for (int i = 0; i < 32; ++i) { const int kk = 2 * i + (lane >> 5); float v = W[(size_t)(k0 + kk) * N + n0 + (lane & 31)]; if (g) v *= g[k0 + kk]; scr[kk * 33 + (lane & 31)] = v; }
    asm volatile("s_waitcnt lgkmcnt(0)" ::: "memory");
    const int c = lane & 7;
#pragma unroll
    for (int j = 0; j < 4; ++j) { const int n = (lane >> 3) + 8 * j; const LAS float* s = scr + (8 * c) * 33 + n;
        u32x4 o; o.x = pk2(s[0 * 33], s[1 * 33]); o.y = pk2(s[2 * 33], s[3 * 33]); o.z = pk2(s[4 * 33], s[5 * 33]); o.w = pk2(s[6 * 33], s[7 * 33]);
        *(u32x4*)(WT + (size_t)(n0 + n) * K + k0 + 8 * c) = o; }
    asm volatile("s_waitcnt lgkmcnt(0)" ::: "memory");
}
__device__ __forceinline__ void rms_row_to_bf16(const float* xrow, const float* g, bf16* orow, int lane) {
    const f32x4* xr = (const f32x4*)xrow + lane; const f32x4* gr = (const f32x4*)g + lane;
    f32x4 v[4]; float s = 0.f;
#pragma unroll
    for (int j = 0; j < 4; ++j) { v[j] = xr[64 * j]; s += (v[j].x * v[j].x + v[j].y * v[j].y) + (v[j].z * v[j].z + v[j].w * v[j].w); }
    const float r = 1.0f / sqrtf(wave_sum(s) * (1.f / DM) + RMS_EPS);
    unsigned long long* o8 = (unsigned long long*)orow + lane;
#pragma unroll
    for (int j = 0; j < 4; ++j) { const f32x4 gg = gr[64 * j]; o8[64 * j] = (unsigned long long)pk2(v[j].x * r * gg.x, v[j].y * r * gg.y) | ((unsigned long long)pk2(v[j].z * r * gg.z, v[j].w * r * gg.w) << 32); }
}

constexpr int KROWB = 144, VROWB = 160, LDS_KOFF = 0, LDS_VOFF = 256 * KROWB, ATT_LDS = LDS_VOFF + 272 * VROWB;
typedef short v4i16_t __attribute__((ext_vector_type(4)));
template <bool WIN>
__device__ __forceinline__ void attn_core(const LAS unsigned char* Kl, const LAS unsigned char* Vl, int q0, bf16x8 qf0, bf16x8 qf1, bool firstblk, int wave, int fr, int fq, f32x4 (&o)[4], float& lse2) {
    constexpr int NT = WIN ? 9 : 16, NK = WIN ? 5 : 8;
    const int kb0 = WIN ? q0 : 0;
    f32x4 s[NT];
#pragma unroll
    for (int t = 0; t < NT; ++t) {
        if (WIN && firstblk && wave + t < 8) { s[t] = (f32x4){-INFINITY, -INFINITY, -INFINITY, -INFINITY}; continue; }
        const LAS unsigned char* kp = Kl + (kb0 + 16 * t + fr) * KROWB + fq * 16;
        const bf16x8 a0 = *(const LAS bf16x8*)kp, a1 = *(const LAS bf16x8*)(kp + 64);
        f32x4 z = (f32x4){0.f, 0.f, 0.f, 0.f};
        z = __builtin_amdgcn_mfma_f32_16x16x32_bf16(a0, qf0, z, 0, 0, 0);
        s[t] = __builtin_amdgcn_mfma_f32_16x16x32_bf16(a1, qf1, z, 0, 0, 0);
    }
    if (WIN) {
        const int dd = fr - 4 * fq; const float NEG = -INFINITY;
#pragma unroll
        for (int i = 0; i < 4; ++i) { if (dd - i > 0) s[0][i] = NEG; if (dd - i < 0) s[NT - 1][i] = NEG; }
    }
    float m = s[0][0];
#pragma unroll
    for (int t = 0; t < NT; ++t) m = fmaxf(fmaxf(m, fmaxf(s[t][0], s[t][1])), fmaxf(s[t][2], s[t][3]));
    m = fmaxf(m, __shfl_xor(m, 16)); m = fmaxf(m, __shfl_xor(m, 32));
    float sum = 0.f;
#pragma unroll
    for (int t = 0; t < NT; ++t) {
#pragma unroll
        for (int i = 0; i < 4; ++i) { s[t][i] = __builtin_amdgcn_exp2f(s[t][i] - m); sum += s[t][i]; } }
    sum += __shfl_xor(sum, 16); sum += __shfl_xor(sum, 32);
    lse2 = m + __builtin_log2f(sum);
    bf16x8 pf[NK];
#pragma unroll
    for (int k = 0; k < NK; ++k) { u32x4 w; w.x = pg8::cvt_pk_bf16(s[2 * k][0], s[2 * k][1]); w.y = pg8::cvt_pk_bf16(s[2 * k][2], s[2 * k][3]);
        if (2 * k + 1 < NT) { w.z = pg8::cvt_pk_bf16(s[2 * k + 1][0], s[2 * k + 1][1]); w.w = pg8::cvt_pk_bf16(s[2 * k + 1][2], s[2 * k + 1][3]); } else { w.z = 0u; w.w = 0u; }
        pf[k] = __builtin_bit_cast(bf16x8, w); }
    const float inv = 1.0f / sum;
#pragma unroll
    for (int dt = 0; dt < 4; ++dt) {
        f32x4 acc = (f32x4){0.f, 0.f, 0.f, 0.f};
#pragma unroll
        for (int k = 0; k < NK; ++k) {
            if (WIN && firstblk && wave + 2 * k + 1 < 8) continue;
            const LAS unsigned char* vp = Vl + (kb0 + 32 * k + 4 * fq + (fr >> 2)) * VROWB + (16 * dt + 4 * (fr & 3)) * 2;
            const v4i16_t lo = __builtin_amdgcn_ds_read_tr16_b64_v4i16((LAS v4i16_t*)vp), hi = __builtin_amdgcn_ds_read_tr16_b64_v4i16((LAS v4i16_t*)(vp + 16 * VROWB));
            const bf16x8 vf = (bf16x8){lo[0], lo[1], lo[2], lo[3], hi[0], hi[1], hi[2], hi[3]};
            acc = __builtin_amdgcn_mfma_f32_16x16x32_bf16(vf, pf[k], acc, 0, 0, 0);
        }
        o[dt] = acc * inv;
    }
}
#define RLX_AGENT __ATOMIC_RELAXED, __HIP_MEMORY_SCOPE_AGENT
#define XB_TMO      128
#define XB_XCNT(j)  (256  + 64 * (j))
#define XB_XSUB(j)  (1280 + 64 * (j))
#define XB_XGEN(j)  (2304 + 64 * (j))
#define XB_TOP      3328
#define XB_TOPGEN   3392
#define XCD_BAR_WORDS 3456
#define XB_SPIN_CAP (1u << 18)

__device__ __forceinline__ unsigned xb_ld(unsigned* p)              { return __hip_atomic_load(p, __ATOMIC_RELAXED, __HIP_MEMORY_SCOPE_AGENT); }
__device__ __forceinline__ unsigned xb_add(unsigned* p, unsigned v) { return __hip_atomic_fetch_add(p, v, __ATOMIC_RELAXED, __HIP_MEMORY_SCOPE_AGENT); }
__device__ __forceinline__ unsigned xb_xcc_id() { return (unsigned)__builtin_amdgcn_s_getreg((3 << 11) | 20) & 0xFu; }
#define XB_SPIN(cond, bar) do { unsigned _sp = 0; while (cond) { __builtin_amdgcn_s_sleep(1); \
    if ((++_sp & 255u) == 0u) { if (xb_ld(&(bar)[XB_TMO])) break; if (_sp > XB_SPIN_CAP) { atomicAdd(&(bar)[XB_TMO], 1u); break; } } } } while (0)

struct XcdBarrier {
    unsigned* bar; unsigned x;
    volatile LAS unsigned* st;
};

__device__ __forceinline__ XcdBarrier xcd_barrier_post(unsigned* bar, volatile LAS unsigned* st) {
    XcdBarrier b; b.bar = bar; b.x = xb_xcc_id(); b.st = st;
    if (threadIdx.x == 0) (void)xb_add(&bar[XB_XCNT(b.x)], 1u);
    return b;
}
__device__ __forceinline__ void xcd_barrier_complete(unsigned* bar, unsigned x, unsigned& nloc, unsigned& nx) {
    const unsigned G = gridDim.x * gridDim.y * gridDim.z;
    unsigned sum, cnt, mine, sp = 0u;
    for (;;) {
        sum = 0u; cnt = 0u; mine = 0u;
#pragma unroll
        for (unsigned j = 0; j < 16; ++j) { const unsigned c = xb_ld(&bar[XB_XCNT(j)]); sum += c; cnt += (c > 0u) ? 1u : 0u; mine = (j == x) ? c : mine; }
        if (sum == G) break;
        __builtin_amdgcn_s_sleep(1);
        if ((++sp & 255u) == 0u) { if (xb_ld(&bar[XB_TMO])) break; if (sp > XB_SPIN_CAP) { atomicAdd(&bar[XB_TMO], 1u); break; } }
    }
    nloc = mine > 0u ? mine : 1u; nx = cnt > 0u ? cnt : 1u;
}

__device__ __forceinline__ void xcd_barrier(const XcdBarrier& b) {
    asm volatile("s_waitcnt vmcnt(0)" ::: "memory");
    __syncthreads();
    if (threadIdx.x == 0) {
        unsigned* bar = b.bar;
        __builtin_amdgcn_s_waitcnt(0);
        unsigned nloc = b.st[0], nx = b.st[1];
        if (nloc == 0u) { xcd_barrier_complete(bar, b.x, nloc, nx); b.st[0] = nloc; b.st[1] = nx; }
        const unsigned old = xb_add(&bar[XB_XSUB(b.x)], 1u);
        const unsigned gen = old / nloc;
        if (old + 1u == (gen + 1u) * nloc) {
            __builtin_amdgcn_fence(__ATOMIC_RELEASE, "agent");
            asm volatile("s_waitcnt vmcnt(0)" ::: "memory");
            const unsigned og = xb_add(&bar[XB_TOP], 1u);
            const unsigned tg = og / nx;
            if (og + 1u == (tg + 1u) * nx) xb_add(&bar[XB_TOPGEN], 1u);
            else XB_SPIN(xb_ld(&bar[XB_TOPGEN]) == tg, bar);
            __builtin_amdgcn_fence(__ATOMIC_ACQUIRE, "agent");
            xb_add(&bar[XB_XGEN(b.x)], 1u);
            asm volatile("s_waitcnt vmcnt(0)" ::: "memory");
        } else {
            XB_SPIN(xb_ld(&bar[XB_XGEN(b.x)]) == gen, bar);
            __builtin_amdgcn_fence(__ATOMIC_ACQUIRE, "agent");
            asm volatile("s_waitcnt vmcnt(0)" ::: "memory");
        }
    }
    __syncthreads();
}

struct Args { const float* x; const float* mem; const int* pos; const float* norm_g; const float* mem_norm_g; const float* w_mem_kv; const float* attn_w_in; const float* attn_w_out;
              const float* conv_w_in; const float* conv_w; const float* conv_w_out; const float* final_g; float* out; unsigned char* ws; int ph_lo, ph_hi; };


struct AttnJob { bf16* proj; int ldp, qcol, zcol; const bf16* kvb; bf16* y; int ldy, ycol, n_mem, n_dil; float* lse; };
struct UnitRegs { u32x4 kv[4], vv[4]; bf16x8 qf0, qf1; u32x2 zr[4]; };
__device__ __forceinline__ void dil_decode(int u, int& b, int& hh, int& g, int& dil, int& r, int& j) {
    b = u / 384; const int rem = u % 384; hh = rem >> 4; const int idx = rem & 15; g = hh >> 3;
    dil = g == 0 ? 1 : (g == 1 ? 4 : 16); const int lgblk = g == 0 ? 4 : (g == 1 ? 2 : 0);
    r = idx >> lgblk; j = idx & ((1 << lgblk) - 1);
}
__device__ __forceinline__ void unit_load(const AttnJob& J, int u, UnitRegs& R, int tid, int wave, int fr, int fq) {
    if (u < J.n_mem) {
        const int b = u >> 6, h = (u >> 4) & 3, qb = u & 15;
        const bf16* Kg = J.kvb + (size_t)b * NMEM * KVW + h * 64;
#pragma unroll
        for (int i = 0; i < 4; ++i) { const int c = tid + NTHR * i, row = c >> 3, ch = c & 7; const size_t off = (size_t)row * KVW + ch * 8;
            R.kv[i] = *(const u32x4*)(Kg + off); R.vv[i] = *(const u32x4*)(Kg + off + 256); }
        const size_t row = (size_t)b * SEQ + qb * 128 + wave * 16 + fr;
        const bf16* qp = J.proj + row * J.ldp + J.qcol + h * 64 + 8 * fq;
        R.qf0 = *(const bf16x8*)qp; R.qf1 = *(const bf16x8*)(qp + 32);
#pragma unroll
        for (int dt = 0; dt < 4; ++dt) R.zr[dt] = *(const u32x2*)(J.proj + row * J.ldp + J.zcol + h * 64 + 16 * dt + 4 * fq);
    } else {
        int b, hh, g, dil, r, j; dil_decode(u - J.n_mem, b, hh, g, dil, r, j);
        const size_t base = (size_t)b * SEQ; const bf16* Kg = J.proj + 1536 + hh * 64;
#pragma unroll
        for (int i = 0; i < 4; ++i) { const int c = tid + NTHR * i, row = c >> 3, ch = c & 7; int p = 128 * (j - 1) + row; p = p < 0 ? 0 : p;
            const size_t off = (base + (size_t)(p * dil + r)) * INA + ch * 8;
            R.kv[i] = *(const u32x4*)(Kg + off); R.vv[i] = *(const u32x4*)(Kg + off + 1536); }
        const size_t row = base + (size_t)((128 * j + wave * 16 + fr) * dil + r);
        const bf16* qp = J.proj + row * INA + hh * 64 + 8 * fq;
        R.qf0 = *(const bf16x8*)qp; R.qf1 = *(const bf16x8*)(qp + 32);
#pragma unroll
        for (int dt = 0; dt < 4; ++dt) R.zr[dt] = (u32x2){0u, 0u};
    }
}
__device__ __forceinline__ void unit_store(const UnitRegs& R, LAS unsigned char* Kl, LAS unsigned char* Vl, int tid) {
#pragma unroll
    for (int i = 0; i < 4; ++i) { const int c = tid + NTHR * i, row = c >> 3, ch = c & 7;
        *(LAS u32x4*)(Kl + row * KROWB + ch * 16) = R.kv[i]; *(LAS u32x4*)(Vl + row * VROWB + ch * 16) = R.vv[i]; }
}
__device__ __forceinline__ void unit_compute(const AttnJob& J, int u, bf16x8 qf0, bf16x8 qf1, const u32x2 (&zr)[4], const LAS unsigned char* Kl, const LAS unsigned char* Vl, int wave, int fr, int fq) {
    f32x4 o[4]; float lse2;
    if (u < J.n_mem) {
        const int b = u >> 6, h = (u >> 4) & 3, qb = u & 15;
        const size_t row = (size_t)b * SEQ + qb * 128 + wave * 16 + fr;
        attn_core<false>(Kl, Vl, 0, qf0, qf1, false, wave, fr, fq, o, lse2);
#pragma unroll
        for (int dt = 0; dt < 4; ++dt) { u32x2 w; w.x = pk2(o[dt][0] * silu(bflo(zr[dt].x)), o[dt][1] * silu(bfhi(zr[dt].x))); w.y = pk2(o[dt][2] * silu(bflo(zr[dt].y)), o[dt][3] * silu(bfhi(zr[dt].y)));
            *(u32x2*)(J.y + row * J.ldy + J.ycol + h * 64 + 16 * dt + 4 * fq) = w; }
    } else {
        int b, hh, g, dil, r, j; dil_decode(u - J.n_mem, b, hh, g, dil, r, j);
        const size_t row = (size_t)b * SEQ + (size_t)((128 * j + wave * 16 + fr) * dil + r);
        attn_core<true>(Kl, Vl, wave * 16, qf0, qf1, j == 0, wave, fr, fq, o, lse2);
        bf16* op = J.proj + row * INA + hh * 64;
#pragma unroll
        for (int dt = 0; dt < 4; ++dt) { u32x2 w; w.x = pk2(o[dt][0], o[dt][1]); w.y = pk2(o[dt][2], o[dt][3]); *(u32x2*)(op + 16 * dt + 4 * fq) = w; }
        if (fq == 0) J.lse[((size_t)g * MT + row) * 8 + (hh & 7)] = lse2;
    }
}
__device__ __forceinline__ void attn_phase(const AttnJob& J, LAS unsigned char* lds, int cb, int G, int tid, int wave, int fr, int fq) {
    const int ntot = J.n_mem + J.n_dil; int u = cb;
    LAS unsigned char* Kl = lds + LDS_KOFF; LAS unsigned char* Vl = lds + LDS_VOFF;
    if (u < ntot) {
        if (tid < 160) *(LAS u32x4*)(Vl + 256 * VROWB + tid * 16) = (u32x4){0u, 0u, 0u, 0u};
        UnitRegs R; unit_load(J, u, R, tid, wave, fr, fq); unit_store(R, Kl, Vl, tid);
        bf16x8 q0 = R.qf0, q1 = R.qf1; u32x2 z[4] = {R.zr[0], R.zr[1], R.zr[2], R.zr[3]};
        __syncthreads();
        for (;;) {
            const int un = u + G; const bool more = un < ntot;
            if (more) unit_load(J, un, R, tid, wave, fr, fq);
            unit_compute(J, u, q0, q1, z, Kl, Vl, wave, fr, fq);
            if (!more) break;
            __syncthreads();
            unit_store(R, Kl, Vl, tid); q0 = R.qf0; q1 = R.qf1; z[0] = R.zr[0]; z[1] = R.zr[1]; z[2] = R.zr[2]; z[3] = R.zr[3]; u = un;
            __syncthreads();
        }
    }
    __syncthreads();
}

__global__ void __launch_bounds__(NTHR, 2) fwd_megakernel(Args a) {
    extern __shared__ __attribute__((aligned(16))) unsigned char lds_raw[];
    LAS unsigned char* lds = (LAS unsigned char*)lds_raw;
    cg::grid_group grid = cg::this_grid();
    const int tid = threadIdx.x, lane = tid & 63, wave = __builtin_amdgcn_readfirstlane(tid >> 6), fr = lane & 15, fq = lane >> 4;
    const int G = gridDim.x, cb = blockIdx.x;
    const int gw = cb * NWAVES + wave, NGW = G * NWAVES;
    const size_t gt = (size_t)cb * NTHR + tid, NGT = (size_t)G * NTHR;
    unsigned char* ws = a.ws;
    bf16* WinA = (bf16*)(ws + WS_WINA); bf16* WinB = (bf16*)(ws + WS_WINB); bf16* WoA = (bf16*)(ws + WS_WOA); bf16* WoB = (bf16*)(ws + WS_WOB); bf16* Wkv = (bf16*)(ws + WS_WKV);
    bf16* KV = (bf16*)(ws + WS_KV); float* LSE = (float*)(ws + WS_LSE); float* ROPE = (float*)(ws + WS_ROPE); float* SSQ = (float*)(ws + WS_SSQ);
    bf16* HN = (bf16*)(ws + WS_HN); bf16* Y = HN; bf16* MEMN = (bf16*)(ws + WS_MEMN); bf16* PROJ = (bf16*)(ws + WS_PROJ); bf16* H1B = (bf16*)(ws + WS_H1B);
    const int lo = a.ph_lo, hi = a.ph_hi;
    if (hi < 0) grid.sync();
    volatile LAS unsigned* MISC = (volatile LAS unsigned*)(lds + MISC_OFF);
    if (tid < 32) MISC[tid] = 0u;
    __syncthreads();
    XcdBarrier bar = xcd_barrier_post((unsigned*)(ws + WS_CTL) + CW_BAR, MISC + 8);
#define IN(k) (lo <= (k) && (k) < hi)
#define SEAM(k) do { if (IN(k) && IN((k) + 1)) { xcd_barrier(bar); if (PROBE_SYNC) xcd_barrier(bar); } } while (0)

    if (IN(0)) for (int rep = 0; rep < REPS(0); ++rep) { const bool dry = (PROBE_PH == 0) && rep == 0; (void)dry;
        LAS float* scr = (LAS float*)(lds + wave * 16384);
        constexpr int I_A = 16 * (INA / 32), I_B = 16 * (INB / 32), I_OA = (BRA / 64) * 32, I_OB = (BRB / 64) * 32, I_KV = 16 * (KVW / 32);
        constexpr int NITEMS = I_A + I_B + I_OA + I_OB + 2 * I_KV;
        for (int it = gw; it < NITEMS; it += NGW) {
            int r = it;
            if (r < I_A) { p0_transpose_item(a.attn_w_in, DM, INA, WinA, nullptr, scr, r, lane); continue; } r -= I_A;
            if (r < I_B) { p0_transpose_item(a.conv_w_in, DM, INB, WinB, a.norm_g + DM, scr, r, lane); continue; } r -= I_B;
            if (r < I_OA) { p0_transpose_item(a.attn_w_out, BRA, DM, WoA, nullptr, scr, r, lane); continue; } r -= I_OA;
            if (r < I_OB) { p0_transpose_item(a.conv_w_out, BRB, DM, WoB, nullptr, scr, r, lane); continue; } r -= I_OB;
            if (r < I_KV) { p0_transpose_item(a.w_mem_kv, DM, KVW, Wkv, nullptr, scr, r, lane); continue; } r -= I_KV;
            p0_transpose_item(a.w_mem_kv + (size_t)DM * KVW, DM, KVW, Wkv + (size_t)KVW * DM, nullptr, scr, r, lane);
        }
        for (int m = gw; m < MT; m += NGW) rms_row_to_bf16(a.x + (size_t)m * DM, a.norm_g, HN + (size_t)m * DM, lane);
        for (int m = gw; m < 2 * MEMROWS; m += NGW) { const int L = m / MEMROWS, mr = m % MEMROWS; rms_row_to_bf16(a.mem + (size_t)mr * DM, a.mem_norm_g + L * DM, MEMN + (size_t)m * DM, lane); }
        for (size_t i = gt; i < (size_t)MT * 8; i += NGT) { const int row = (int)(i >> 3), j = (int)(i & 7);
            const float inv = (float)pow(500000.0, -(double)j * 0.125); const float ang = (float)a.pos[row] * inv;
            ROPE[(size_t)row * 16 + j] = (float)cos((double)ang); ROPE[(size_t)row * 16 + 8 + j] = (float)sin((double)ang); }
    }
    SEAM(0);
    if (IN(1)) for (int rep = 0; rep < REPS(1); ++rep) { const bool dry = (PROBE_PH == 1) && rep == 0; (void)dry;
        { pg8::Gemm g{HN, WinA, MT, INA, DM}; pg8::StaticOrder S; S.init(MT, INA, G, cb); pg8::EpiProj0 E{PROJ, INA, ROPE};
          pg8::gemm_phase<pg8::EpiProj0, pg8::StaticOrder, true, true>(lds, g, S, E); }
        const int c1 = cb - G / 2;
        if (c1 >= 0 && c1 < 16) { pg8::Gemm g{MEMN, Wkv, MEMROWS, KVW, DM}; pg8::StaticOrder S; S.init(MEMROWS, KVW, G, c1); pg8::EpiPlain E{KV, KVW};
          pg8::gemm_phase<pg8::EpiPlain, pg8::StaticOrder, true, true>(lds, g, S, E); }
        if (c1 >= 16 && c1 < 32) { pg8::Gemm g{MEMN + (size_t)MEMROWS * DM, Wkv + (size_t)KVW * DM, MEMROWS, KVW, DM}; pg8::StaticOrder S; S.init(MEMROWS, KVW, G, c1 - 16); pg8::EpiPlain E{KV + (size_t)MEMROWS * KVW, KVW};
          pg8::gemm_phase<pg8::EpiPlain, pg8::StaticOrder, true, true>(lds, g, S, E); }
    }
    SEAM(1);
    if (IN(2)) for (int rep = 0; rep < REPS(2); ++rep) { const bool dry = (PROBE_PH == 2) && rep == 0; (void)dry;
        const AttnJob J{PROJ, INA, 4608, 4864 + 512, KV, Y, BRA, 512, 512, 3072, LSE};
        attn_phase(J, lds, cb, G, tid, wave, fr, fq);
    }
    SEAM(2);
    if (IN(3)) for (int rep = 0; rep < REPS(3); ++rep) { const bool dry = (PROBE_PH == 3) && rep == 0; (void)dry;
        for (size_t it = gt; it < (size_t)MT * 64; it += NGT) { const size_t row = it >> 6; const int c = (int)(it & 63), h = c >> 3;
            const float l0 = LSE[row * 8 + h], l1 = LSE[((size_t)MT + row) * 8 + h], l2 = LSE[((size_t)2 * MT + row) * 8 + h];
            const float mx = fmaxf(l0, fmaxf(l1, l2)); float w0 = __builtin_amdgcn_exp2f(l0 - mx), w1 = __builtin_amdgcn_exp2f(l1 - mx), w2 = __builtin_amdgcn_exp2f(l2 - mx);
            const float inv = 1.0f / (w0 + w1 + w2); w0 *= inv; w1 *= inv; w2 *= inv;
            const bf16* pr = PROJ + row * INA + c * 8;
            const u32x4 o0 = *(const u32x4*)pr, o1 = *(const u32x4*)(pr + 512), o2 = *(const u32x4*)(pr + 1024), z = *(const u32x4*)(pr + 4864);
            u32x4 y;
#pragma unroll
            for (int k = 0; k < 4; ++k) { const float mlo = w0 * bflo(o0[k]) + w1 * bflo(o1[k]) + w2 * bflo(o2[k]), mhi = w0 * bfhi(o0[k]) + w1 * bfhi(o1[k]) + w2 * bfhi(o2[k]);
                y[k] = pk2(mlo * silu(bflo(z[k])), mhi * silu(bfhi(z[k]))); }
            *(u32x4*)(Y + row * BRA + c * 8) = y; }
    }
    SEAM(3);
    if (IN(4)) for (int rep = 0; rep < REPS(4); ++rep) { const bool dry = (PROBE_PH == 4) && rep == 0; (void)dry;
        pg8::Gemm g{Y, WoA, MT, DM, BRA}; pg8::StaticOrder S; S.init(MT, DM, G, cb); pg8::EpiH1 E{a.x, a.out, H1B, SSQ};
        pg8::gemm_phase<pg8::EpiH1, pg8::StaticOrder, true, true>(lds, g, S, E);
    }
    SEAM(4);
    if (IN(5)) for (int rep = 0; rep < REPS(5); ++rep) { const bool dry = (PROBE_PH == 5) && rep == 0; (void)dry;
        pg8::Gemm g{H1B, WinB, MT, INB, DM}; pg8::StaticOrder S; S.init(MT, INB, G, cb); pg8::EpiProj1 E{PROJ, INB, SSQ};
        pg8::gemm_phase<pg8::EpiProj1, pg8::StaticOrder, true, true>(lds, g, S, E);
    }
    SEAM(5);
    if (IN(6)) for (int rep = 0; rep < REPS(6); ++rep) { const bool dry = (PROBE_PH == 6) && rep == 0; (void)dry;
        { const AttnJob J{PROJ, INB, 3072, 3328 + 1024, KV + (size_t)MEMROWS * KVW, Y, BRB, 1024, 512, 0, LSE};
          attn_phase(J, lds, cb, G, tid, wave, fr, fq); }
        for (size_t it = gt; it < (size_t)(MT / 16) * 128; it += NGT) { const size_t t0 = (it >> 7) * 16; const int c = (int)(it & 127);
            const f32x4* cw = (const f32x4*)(a.conv_w + c * 8);
            const f32x4 w0a = cw[0], w0b = cw[1], w1a = cw[256], w1b = cw[257], w2a = cw[512], w2b = cw[513];
            float w0[8] = {w0a[0], w0a[1], w0a[2], w0a[3], w0b[0], w0b[1], w0b[2], w0b[3]}, w1[8] = {w1a[0], w1a[1], w1a[2], w1a[3], w1b[0], w1b[1], w1b[2], w1b[3]},
                  w2[8] = {w2a[0], w2a[1], w2a[2], w2a[3], w2b[0], w2b[1], w2b[2], w2b[3]};
            float am2[8], am1[8];
            if ((t0 & (SEQ - 1)) == 0) {
#pragma unroll
                for (int k = 0; k < 8; ++k) { am2[k] = 0.f; am1[k] = 0.f; }
            } else { const bf16* p2 = PROJ + (t0 - 2) * INB + c * 8; const bf16* p1 = PROJ + (t0 - 1) * INB + c * 8;
                const u32x4 c2 = *(const u32x4*)(p2 + 1024), u2 = *(const u32x4*)(p2 + 2048), c1 = *(const u32x4*)(p1 + 1024), u1 = *(const u32x4*)(p1 + 2048);
#pragma unroll
                for (int k = 0; k < 4; ++k) { am2[2 * k] = bflo(c2[k]) * bflo(u2[k]); am2[2 * k + 1] = bfhi(c2[k]) * bfhi(u2[k]); am1[2 * k] = bflo(c1[k]) * bflo(u1[k]); am1[2 * k + 1] = bfhi(c1[k]) * bfhi(u1[k]); } }
#pragma unroll 4
            for (int tt = 0; tt < 16; ++tt) { const bf16* p = PROJ + (t0 + tt) * INB + c * 8;
                const u32x4 bg = *(const u32x4*)p, cg_ = *(const u32x4*)(p + 1024), uu = *(const u32x4*)(p + 2048), zz = *(const u32x4*)(p + 3328);
                float a0[8], yv[8];
#pragma unroll
                for (int k = 0; k < 4; ++k) { a0[2 * k] = bflo(cg_[k]) * bflo(uu[k]); a0[2 * k + 1] = bfhi(cg_[k]) * bfhi(uu[k]); }
#pragma unroll
                for (int k = 0; k < 8; ++k) { const float cv = w0[k] * am2[k] + w1[k] * am1[k] + w2[k] * a0[k]; const unsigned bw = bg[k >> 1], zw = zz[k >> 1];
                    const float bgv = (k & 1) ? bfhi(bw) : bflo(bw), zv = (k & 1) ? bfhi(zw) : bflo(zw); yv[k] = bgv * cv * silu(zv); am2[k] = am1[k]; am1[k] = a0[k]; }
                u32x4 y; y.x = pk2(yv[0], yv[1]); y.y = pk2(yv[2], yv[3]); y.z = pk2(yv[4], yv[5]); y.w = pk2(yv[6], yv[7]);
                *(u32x4*)(Y + (t0 + tt) * BRB + c * 8) = y; } }
    }
    SEAM(6);
    if (IN(7)) for (int rep = 0; rep < REPS(7); ++rep) { const bool dry = (PROBE_PH == 7) && rep == 0; (void)dry;
        pg8::Gemm g{Y, WoB, MT, DM, BRB}; pg8::StaticOrder S; S.init(MT, DM, G, cb); pg8::EpiH2 E{a.out, dry ? (float*)PROJ : a.out};
        pg8::gemm_phase<pg8::EpiH2, pg8::StaticOrder, true, true>(lds, g, S, E);
    }
    SEAM(7);
    if (IN(8)) for (int rep = 0; rep < REPS(8); ++rep) { const bool dry = (PROBE_PH == 8) && rep == 0; (void)dry;
        for (int m = gw; m < MT; m += NGW) { f32x4* xr = (f32x4*)(a.out + (size_t)m * DM) + lane; const f32x4* gr = (const f32x4*)a.final_g + lane; f32x4* xo = dry ? (f32x4*)((float*)PROJ + (size_t)m * DM) + lane : xr;
            f32x4 v[4]; float s = 0.f;
#pragma unroll
            for (int j = 0; j < 4; ++j) { v[j] = xr[64 * j]; s += (v[j].x * v[j].x + v[j].y * v[j].y) + (v[j].z * v[j].z + v[j].w * v[j].w); }
            const float r = 1.0f / sqrtf(wave_sum(s) * (1.f / DM) + RMS_EPS);
#pragma unroll
            for (int j = 0; j < 4; ++j) xo[64 * j] = v[j] * r * gr[64 * j]; }
    }
#undef IN
#undef SEAM
}

constexpr int N_PHASES = 9;
extern "C" void kernel_launch(void* const* d_in, const int* in_sizes, int n_in, void* d_out, int out_size, void* d_ws, size_t ws_size, hipStream_t stream) {
    static int grid = 0;
    if (grid == 0) {
        int dev = 0, cus = 0, per_cu = 0;
        hipGetDevice(&dev); hipDeviceGetAttribute(&cus, hipDeviceAttributeMultiprocessorCount, dev);
        if (hipFuncSetAttribute((const void*)fwd_megakernel, hipFuncAttributeMaxDynamicSharedMemorySize, LDS_BYTES) != hipSuccess) fprintf(stderr, "kernel_launch: hipFuncSetAttribute failed\n");
        if (hipOccupancyMaxActiveBlocksPerMultiprocessor(&per_cu, (const void*)fwd_megakernel, NTHR, LDS_BYTES) != hipSuccess || per_cu < 1) { fprintf(stderr, "kernel_launch: occupancy query gave %d\n", per_cu); per_cu = 1; }
        (void)hipGetLastError();
        grid = cus * 1;
        if (ws_size < WS_END) { fprintf(stderr, "kernel_launch: workspace too small (%zu)\n", ws_size); grid = -1; }
    }
    if (grid < 0) return;
    if (hipMemsetAsync((char*)d_ws + WS_CTL, 0, CTL_ZERO_BYTES, stream) != hipSuccess) { fprintf(stderr, "kernel_launch: memset failed\n"); return; }
    Args a{};
    a.x = (const float*)d_in[0]; a.mem = (const float*)d_in[1]; a.pos = (const int*)d_in[2]; a.norm_g = (const float*)d_in[3]; a.mem_norm_g = (const float*)d_in[4];
    a.w_mem_kv = (const float*)d_in[5]; a.attn_w_in = (const float*)d_in[6]; a.attn_w_out = (const float*)d_in[7]; a.conv_w_in = (const float*)d_in[8];
    a.conv_w = (const float*)d_in[9]; a.conv_w_out = (const float*)d_in[10]; a.final_g = (const float*)d_in[11]; a.out = (float*)d_out; a.ws = (unsigned char*)d_ws;
#if MK_PER_PHASE
    for (int p = 0; p < N_PHASES; ++p) { a.ph_lo = p; a.ph_hi = p + 1; hipLaunchKernelGGL(fwd_megakernel, dim3(grid), dim3(NTHR), LDS_BYTES, stream, a); }
#else
    a.ph_lo = 0; a.ph_hi = N_PHASES;
    void* args[] = {&a};
    hipError_t e = hipLaunchCooperativeKernel((const void*)fwd_megakernel, dim3(grid), dim3(NTHR), args, LDS_BYTES, stream);
    if (e != hipSuccess) fprintf(stderr, "kernel_launch: cooperative launch failed: %s (grid %d)\n", hipGetErrorString(e), grid);
#endif
}
```
